# Optimizing an MI355X kernel written in HIP

```python
import math
import jax, jax.numpy as jnp
from jax import lax
import numpy as np

D_MODEL = 1024
BATCH = 32
SEQ = 2048
DEPTH = 1

D_MIX = D_MODEL
D_HYENA = D_MIX // 2
D_ATTN = D_MIX - D_HYENA
HEAD_DIM = 64
N_Q_HEADS = D_ATTN // HEAD_DIM
N_KV_HEADS = N_Q_HEADS // 4
GQA_GROUP = N_Q_HEADS // N_KV_HEADS
WINDOW = 128
BLOCK = 128
ROPE_THETA = 10000.0
HYENA_ORDER = 2
SHORT_CONV = 3
FILTER_EMB = 33
FILTER_HIDDEN = 64
N_DIRS = 2
DECAY_TARGET = 1e-2
FAST_DECAY_PCT = 0.3
SLOW_DECAY_PCT = 1.5
EPS = 1e-6

N_HY_PROJ = (HYENA_ORDER + 1) * D_HYENA
D_KV = N_KV_HEADS * HEAD_DIM
D_IN = N_HY_PROJ + D_HYENA + D_ATTN + 2 * D_KV + D_ATTN

kernel_name = "hymba_hyena_swa_hybrid_encoder"

F32 = jnp.float32


def rms_norm(x, g):
    xf = x.astype(F32)
    y = xf * lax.rsqrt(jnp.mean(xf * xf, axis=-1, keepdims=True) + EPS)
    return (y * g.astype(F32)).astype(x.dtype)


def centred_short_conv(u, w, b):
    L = u.shape[1]
    half = SHORT_CONV // 2
    up = jnp.pad(u, ((0, 0), (half, half), (0, 0)))
    out = b
    for j in range(SHORT_CONV):
        out = out + up[:, j:j + L] * w[j]
    return out


def hyena_filters(L, w1, b1, w2, b2, w3, b3, w4, sin_freq):
    t = jnp.linspace(0.0, 1.0, L, dtype=F32)[:, None]
    bands = (FILTER_EMB - 1) // 2
    f = jnp.linspace(1e-4, bands - 1, bands, dtype=F32)[None, :]
    w = 2.0 * math.pi * jnp.arange(L, dtype=F32)[:, None] / L
    z = jnp.concatenate([t, jnp.cos(f * w), -jnp.sin(f * w)], axis=-1)
    fr = sin_freq.astype(F32)
    h = jnp.sin(fr * (z @ w1.astype(F32) + b1.astype(F32)))
    h = jnp.sin(fr * (h @ w2.astype(F32) + b2.astype(F32)))
    h = jnp.sin(fr * (h @ w3.astype(F32) + b3.astype(F32)))
    h = (h @ w4.astype(F32)).reshape(L, HYENA_ORDER, N_DIRS, D_HYENA)
    max_decay = math.log(DECAY_TARGET) / FAST_DECAY_PCT
    min_decay = math.log(DECAY_TARGET) / SLOW_DECAY_PCT
    deltas = jnp.linspace(min_decay, max_decay, D_HYENA, dtype=F32)
    decay = jnp.exp(-t * jnp.abs(deltas)[None, :])
    return h * decay[:, None, None, :]


def two_sided_spectrum(h):
    L = h.shape[0]
    zero = jnp.zeros((1,) + h.shape[1:2] + h.shape[3:], F32)
    k = jnp.concatenate([h[:, :, 0], zero, h[1:, :, 1][::-1]], axis=0)
    return jnp.fft.rfft(k, n=2 * L, axis=0)


def long_conv(u, k_f, bias):
    L = u.shape[1]
    y = jnp.fft.irfft(jnp.fft.rfft(u, n=2 * L, axis=1) * k_f[None], n=2 * L, axis=1)[:, :L]
    return y + u * bias


def rope(x, pos):
    half = HEAD_DIM // 2
    inv = ROPE_THETA ** (-jnp.arange(half, dtype=F32) / half)
    ang = pos[:, None] * inv[None, :]
    cos = jnp.cos(ang)[None, :, None, :]
    sin = jnp.sin(ang)[None, :, None, :]
    xf = x.astype(F32)
    x1, x2 = xf[..., :half], xf[..., half:]
    return jnp.concatenate([x1 * cos - x2 * sin, x2 * cos + x1 * sin], axis=-1).astype(x.dtype)


def windowed_sink_attention(q, k, v, sink):
    B, S = q.shape[0], q.shape[1]
    nb = S // BLOCK
    span = BLOCK + 2 * WINDOW
    kp = jnp.pad(k, ((0, 0), (WINDOW, WINDOW), (0, 0), (0, 0)))
    vp = jnp.pad(v, ((0, 0), (WINDOW, WINDOW), (0, 0), (0, 0)))
    qb = q.reshape(B, nb, BLOCK, N_KV_HEADS, GQA_GROUP, HEAD_DIM).transpose(1, 0, 2, 3, 4, 5)
    scale = HEAD_DIM ** -0.5
    sink32 = sink.astype(F32)[None, :, :, None, None]

    def block(args):
        qi, i = args
        start = i * BLOCK
        kw = lax.dynamic_slice_in_dim(kp, start, span, axis=1)
        vw = lax.dynamic_slice_in_dim(vp, start, span, axis=1)
        s = jnp.einsum('bqkgd,bskd->bkgqs', qi.astype(F32), kw.astype(F32)) * scale
        qpos = start + jnp.arange(BLOCK)
        kpos = start - WINDOW + jnp.arange(span)
        valid = ((jnp.abs(kpos[None, :] - qpos[:, None]) <= WINDOW)
                 & (kpos >= 0)[None, :] & (kpos < S)[None, :])
        s = jnp.where(valid, s, -jnp.inf)
        m = jnp.maximum(jnp.max(s, axis=-1, keepdims=True), sink32)
        p = jnp.exp(s - m)
        denom = jnp.sum(p, axis=-1, keepdims=True) + jnp.exp(sink32 - m)
        o = jnp.einsum('bkgqs,bskd->bqkgd', p / denom, vw.astype(F32))
        return o.astype(q.dtype)

    out = lax.map(block, (qb, jnp.arange(nb)))
    return out.transpose(1, 0, 2, 3, 4, 5).reshape(B, S, N_Q_HEADS * HEAD_DIM)


def setup_inputs(seed: int = 0) -> dict:
    key = jax.random.key(seed)
    ks = jax.random.split(key, 24)
    nrm = lambda k, shape, s: jax.random.normal(k, shape, F32) * s
    return {
        'x': nrm(ks[0], (BATCH, SEQ, D_MODEL), 1.0),
        'norm_g': 1.0 + nrm(ks[1], (DEPTH, D_MODEL), 0.02),
        'w_in': nrm(ks[2], (DEPTH, D_MODEL, D_IN), D_MODEL ** -0.5),
        'conv_w': nrm(ks[3], (DEPTH, SHORT_CONV, N_HY_PROJ), SHORT_CONV ** -0.5),
        'conv_b': nrm(ks[4], (DEPTH, N_HY_PROJ), 0.01),
        'filt_w1': nrm(ks[5], (DEPTH, FILTER_EMB, FILTER_HIDDEN), FILTER_EMB ** -0.5),
        'filt_b1': nrm(ks[6], (DEPTH, FILTER_HIDDEN), 0.1),
        'filt_w2': nrm(ks[7], (DEPTH, FILTER_HIDDEN, FILTER_HIDDEN), FILTER_HIDDEN ** -0.5),
        'filt_b2': nrm(ks[8], (DEPTH, FILTER_HIDDEN), 0.1),
        'filt_w3': nrm(ks[9], (DEPTH, FILTER_HIDDEN, FILTER_HIDDEN), FILTER_HIDDEN ** -0.5),
        'filt_b3': nrm(ks[10], (DEPTH, FILTER_HIDDEN), 0.1),
        'filt_w4': nrm(ks[11], (DEPTH, FILTER_HIDDEN, HYENA_ORDER * N_DIRS * D_HYENA), FILTER_HIDDEN ** -0.5),
        'filt_sin_freq': 1.0 + nrm(ks[12], (DEPTH, FILTER_HIDDEN), 0.02),
        'hyena_bias': nrm(ks[13], (DEPTH, HYENA_ORDER, D_HYENA), 1.0),
        'q_norm_g': 1.0 + nrm(ks[14], (DEPTH, HEAD_DIM), 0.02),
        'k_norm_g': 1.0 + nrm(ks[15], (DEPTH, HEAD_DIM), 0.02),
        'attn_sink': nrm(ks[16], (DEPTH, N_Q_HEADS), 0.5),
        'hy_out_norm_g': 1.0 + nrm(ks[17], (DEPTH, D_HYENA), 0.02),
        'attn_out_norm_g': 1.0 + nrm(ks[18], (DEPTH, D_ATTN), 0.02),
        'w_out': nrm(ks[19], (DEPTH, D_MIX, D_MODEL), D_MIX ** -0.5),
    }


def reference(x, norm_g, w_in, conv_w, conv_b, filt_w1, filt_b1, filt_w2, filt_b2,
              filt_w3, filt_b3, filt_w4, filt_sin_freq, hyena_bias, q_norm_g, k_norm_g,
              attn_sink, hy_out_norm_g, attn_out_norm_g, w_out):
    B, S = x.shape[0], x.shape[1]
    pos = jnp.arange(S, dtype=F32)
    for l in range(DEPTH):
        h = rms_norm(x, norm_g[l])
        proj = h @ w_in[l]
        o0 = N_HY_PROJ
        o1 = o0 + D_HYENA
        o2 = o1 + D_ATTN
        o3 = o2 + D_KV
        o4 = o3 + D_KV
        hy_in, g_h = proj[..., :o0], proj[..., o0:o1]
        q, k, v = proj[..., o1:o2], proj[..., o2:o3], proj[..., o3:o4]
        g_a = proj[..., o4:]

        u = centred_short_conv(hy_in, conv_w[l], conv_b[l]).astype(F32)
        hv, hx1, hx2 = jnp.split(u, HYENA_ORDER + 1, axis=-1)
        filt = hyena_filters(S, filt_w1[l], filt_b1[l], filt_w2[l], filt_b2[l],
                             filt_w3[l], filt_b3[l], filt_w4[l], filt_sin_freq[l])
        k_f = two_sided_spectrum(filt)
        hb = hyena_bias[l].astype(F32)
        z = hx1 * long_conv(hv, k_f[:, 0], hb[0])
        z = hx2 * long_conv(z, k_f[:, 1], hb[1])
        y_h = z.astype(x.dtype)

        q = rms_norm(q.reshape(B, S, N_Q_HEADS, HEAD_DIM), q_norm_g[l])
        k = rms_norm(k.reshape(B, S, N_KV_HEADS, HEAD_DIM), k_norm_g[l])
        q = rope(q, pos).reshape(B, S, N_KV_HEADS, GQA_GROUP, HEAD_DIM)
        k = rope(k, pos)
        v = v.reshape(B, S, N_KV_HEADS, HEAD_DIM)
        y_a = windowed_sink_attention(q, k, v, attn_sink[l].reshape(N_KV_HEADS, GQA_GROUP))

        y = jnp.concatenate([rms_norm(y_h, hy_out_norm_g[l]) * jax.nn.silu(g_h),
                             rms_norm(y_a, attn_out_norm_g[l]) * jax.nn.silu(g_a)], axis=-1)
        x = x + y @ w_out[l]
    return x
```

```cpp
#include <hip/hip_runtime.h>
#include <hip/hip_cooperative_groups.h>
#include <cstdio>
namespace cg = cooperative_groups;
namespace pg8 {
#define PG8_LAS __attribute__((address_space(3)))
typedef unsigned short bf16_t;
typedef short bf16x8 __attribute__((ext_vector_type(8)));
typedef float f32x4 __attribute__((ext_vector_type(4)));
typedef unsigned u32x4 __attribute__((ext_vector_type(4)));
constexpr int BM = 256, BK = 64, HALF = 128, HTB = HALF * BK * 2  , STAGE_BYTES = 8 * HTB, NXCD = 8, WGM = 4;

__host__ __device__ __forceinline__ int lds_byte(int r, int c) { const int st = (r >> 4) * 2 + (c >> 5), rr = r & 15, cc = c & 31, ob = rr * 64 + cc * 2; return st * 1024 + (ob ^ (((ob >> 9) & 1) << 5)); }
__host__ __device__ __forceinline__ void stage_rc(int b, int& R, int& C) { const int st = b / 1024, sb = b % 1024, swz = sb ^ (((sb >> 9) & 1) << 5); R = (st >> 1) * 16 + swz / 64; C = (st & 1) * 32 + (swz % 64) / 2; }
__host__ __device__ __forceinline__ int perm32(int rho) { const int n = rho >> 4, i = rho & 15; return 8 * (i >> 2) + 4 * n + (i & 3); }

struct Unit { int pm, pn; };
struct Gemm { const bf16_t* A; const bf16_t* Bt; int M, N, K; };

struct StaticOrder {
    int nM, nN, nwg, G, c;
    __host__ __device__ void init(int M, int N, int G_, int c_) { nM = M / BM; nN = N / BM; nwg = nM * nN; G = G_; c = c_; }
    __host__ __device__ bool next(int i, Unit& u) const {
        const long L = (long)i * G + c; if (L >= nwg) return false;
        int wgid = (int)L; { const int q = nwg / NXCD, r = nwg % NXCD, xcd = wgid % NXCD, off = wgid / NXCD; wgid = (xcd < r ? xcd * (q + 1) : r * (q + 1) + (xcd - r) * q) + off; }
        const int nig = WGM * nN, gid = wgid / nig, fm = gid * WGM, gsz = (nM - fm) < WGM ? (nM - fm) : WGM;
        u.pm = fm + ((wgid % nig) % gsz); u.pn = (wgid % nig) / gsz; return true;
    }
    __device__ __forceinline__ void a_ready(const Unit&) const {}
    __device__ __forceinline__ void done(const Unit&) const {}
};

template <class Epi, class Sched, bool ALIGN_EPI = false, bool SP2 = false>
__device__ __forceinline__ void gemm_phase2(PG8_LAS unsigned char* lds, const Gemm g, const Sched& S, const Epi& E) {
    int tid_raw = threadIdx.x; asm volatile("" : "+v"(tid_raw));
    const int tid = tid_raw, wid = __builtin_amdgcn_readfirstlane(tid >> 6), lane = tid & 63, wr = wid >> 2, wc = wid & 3, fr = lane & 15, fq = lane >> 4;
    const int K = g.K, nt = K / BK;
    unsigned voffA[2], voffB[2];
#pragma unroll
    for (int i = 0; i < 2; ++i) { int R, C; stage_rc(tid * 16 + i * 8192, R, C); const int Rb = Epi::PERM ? ((R & ~31) + perm32(R & 31)) : R;
        const int Ra = Epi::APERM ? (128 * (R >> 6) + 8 * (R & 15) + ((R >> 4) & 3)) : R; voffA[i] = (unsigned)(Ra * K + C) * 2u; voffB[i] = (unsigned)(Rb * K + C) * 2u; }
    const size_t kstep = (size_t)(BK * 2);
    const size_t hstep = (size_t)HALF * K * 2;
    const size_t tstep = 2 * hstep;
    const size_t hstepA = Epi::APERM ? (size_t)4 * K * 2 : hstep;
    const unsigned ldsw = (unsigned)wid * 1024u;
    const int aoff = lds_byte(wr * 64 + fr, fq * 8), boff = lds_byte(wc * 32 + fr, fq * 8);
#define PG8_SA(b, h) (((b) * 2 + (h)) * HTB)
#define PG8_SB(b, h) ((4 + (b) * 2 + (h)) * HTB)
#define PG8_STAGE(bufoff, gbase, voff) do { _Pragma("unroll") for (int _i = 0; _i < 2; ++_i) \
        __builtin_amdgcn_global_load_lds((const unsigned*)((const char*)(gbase) + (voff)[_i]), (PG8_LAS unsigned*)(lds + (bufoff) + ldsw + _i * 8192), 16, 0, 0); } while (0)
#define PG8_LDA(dst, b, h) do { _Pragma("unroll") for (int m = 0; m < 4; ++m) _Pragma("unroll") for (int k = 0; k < 2; ++k) dst[m][k] = *(const PG8_LAS bf16x8*)(lds + PG8_SA(b, h) + aoff + m * 2048 + k * 1024); } while (0)
#define PG8_LDB(dst, b, h) do { _Pragma("unroll") for (int n = 0; n < 2; ++n) _Pragma("unroll") for (int k = 0; k < 2; ++k) dst[n][k] = *(const PG8_LAS bf16x8*)(lds + PG8_SB(b, h) + boff + n * 2048 + k * 1024); } while (0)
#define PG8_MMA(ai, bj, At, Bt) do { __builtin_amdgcn_s_setprio(1); _Pragma("unroll") for (int m = 0; m < 4; ++m) _Pragma("unroll") for (int n = 0; n < 2; ++n) _Pragma("unroll") for (int k = 0; k < 2; ++k) \
        acc[ai][bj][m][n] = __builtin_amdgcn_mfma_f32_16x16x32_bf16(Bt[n][k], At[m][k], acc[ai][bj][m][n], 0, 0, 0); __builtin_amdgcn_s_setprio(0); } while (0)
#define PG8_WAIT_V(n) asm volatile("s_waitcnt vmcnt(" #n ")" ::: "memory")
#define PG8_WAIT_L(n) asm volatile("s_waitcnt lgkmcnt(" #n ")" ::: "memory")
#define PG8_BAR __builtin_amdgcn_s_barrier()
#define PG8_SCHED __builtin_amdgcn_sched_barrier(0)
    Unit cur, nxt; int ui = 0;
    if (!S.next(0, cur)) return;
    f32x4 acc[2][2][4][2];
#pragma unroll
    for (int a = 0; a < 2; ++a)
#pragma unroll
        for (int b = 0; b < 2; ++b)
#pragma unroll
            for (int m = 0; m < 4; ++m)
#pragma unroll
                for (int n = 0; n < 2; ++n) acc[a][b][m][n] = (f32x4){0.f, 0.f, 0.f, 0.f};
    bf16x8 At[4][2], B0[2][2], B1[2][2];
    const char* cA = (const char*)g.A + (size_t)cur.pm * tstep; const char* cB = (const char*)g.Bt + (size_t)cur.pn * tstep;
    S.a_ready(cur);
    if constexpr (SP2) {
        PG8_STAGE(PG8_SB(0, 0), cB, voffB); PG8_STAGE(PG8_SB(0, 1), cB + hstep, voffB); PG8_STAGE(PG8_SA(0, 0), cA, voffA); PG8_STAGE(PG8_SA(0, 1), cA + hstepA, voffA);
        if (wr == 1) PG8_BAR;
        PG8_WAIT_V(2); PG8_BAR;
        PG8_STAGE(PG8_SB(1, 0), cB + kstep, voffB); PG8_STAGE(PG8_SA(1, 0), cA + kstep, voffA); PG8_STAGE(PG8_SB(1, 1), cB + hstep + kstep, voffB);
        PG8_WAIT_V(6); PG8_BAR;
    } else {
        PG8_STAGE(PG8_SB(0, 0), cB, voffB); PG8_STAGE(PG8_SA(0, 0), cA, voffA); PG8_STAGE(PG8_SB(0, 1), cB + hstep, voffB); PG8_STAGE(PG8_SA(0, 1), cA + hstepA, voffA);
        if (wr == 1) PG8_BAR;
        PG8_WAIT_V(4); PG8_BAR;
        PG8_STAGE(PG8_SB(1, 0), cB + kstep, voffB); PG8_STAGE(PG8_SA(1, 0), cA + kstep, voffA); PG8_STAGE(PG8_SB(1, 1), cB + hstep + kstep, voffB);
        PG8_WAIT_V(6); PG8_BAR;
    }
    for (;;) {
        const bool has_next = S.next(ui + 1, nxt);
        const char* nA = has_next ? (const char*)g.A + (size_t)nxt.pm * tstep : cA; const char* nB = has_next ? (const char*)g.Bt + (size_t)nxt.pn * tstep : cB;
        for (int t = 0; t < nt; t += 2) {
            const bool last = (t == nt - 2);
            const char* a1 = cA + (size_t)(t + 1) * kstep;
            const char* a2 = last ? nA : cA + (size_t)(t + 2) * kstep; const char* b2 = last ? nB : cB + (size_t)(t + 2) * kstep;
            const char* a3 = a2 + kstep; const char* b3 = b2 + kstep;
            if (last && has_next) S.a_ready(nxt);
            if constexpr (SP2) {
            PG8_LDB(B0, 0, 0); PG8_LDB(B1, 0, 1); PG8_SCHED; PG8_LDA(At, 0, 0); PG8_STAGE(PG8_SA(1, 1), a1 + hstepA, voffA);
            PG8_WAIT_V(8); PG8_WAIT_L(0); PG8_BAR; PG8_MMA(0, 0, At, B0); PG8_MMA(0, 1, At, B1); PG8_BAR; PG8_SCHED;
            PG8_LDA(At, 0, 1); PG8_STAGE(PG8_SB(0, 0), b2, voffB); PG8_STAGE(PG8_SB(0, 1), b2 + hstep, voffB); PG8_STAGE(PG8_SA(0, 0), a2, voffA);
            PG8_WAIT_V(8); PG8_WAIT_L(0); PG8_BAR; PG8_MMA(1, 0, At, B0); PG8_MMA(1, 1, At, B1); PG8_BAR; PG8_SCHED;
            PG8_LDB(B0, 1, 0); PG8_LDB(B1, 1, 1); PG8_SCHED; PG8_LDA(At, 1, 0); PG8_STAGE(PG8_SA(0, 1), a2 + hstepA, voffA);
            PG8_WAIT_V(8); PG8_WAIT_L(0); PG8_BAR; PG8_MMA(0, 0, At, B0); PG8_MMA(0, 1, At, B1); PG8_BAR; PG8_SCHED;
            PG8_LDA(At, 1, 1); PG8_STAGE(PG8_SB(1, 0), b3, voffB); PG8_STAGE(PG8_SB(1, 1), b3 + hstep, voffB); PG8_STAGE(PG8_SA(1, 0), a3, voffA);
            PG8_WAIT_V(8); PG8_WAIT_L(0); PG8_BAR; PG8_MMA(1, 0, At, B0); PG8_MMA(1, 1, At, B1); PG8_BAR; PG8_SCHED;
            } else {
            PG8_LDB(B0, 0, 0); PG8_SCHED; PG8_LDA(At, 0, 0); PG8_STAGE(PG8_SA(1, 1), a1 + hstepA, voffA);
            PG8_WAIT_L(8); PG8_BAR; PG8_WAIT_L(0); PG8_MMA(0, 0, At, B0); PG8_BAR; PG8_SCHED;
            PG8_LDB(B1, 0, 1); PG8_STAGE(PG8_SB(0, 0), b2, voffB);
            PG8_BAR; PG8_WAIT_L(0); PG8_MMA(0, 1, At, B1); PG8_BAR;
            PG8_LDA(At, 0, 1); PG8_STAGE(PG8_SA(0, 0), a2, voffA);
            PG8_BAR; PG8_WAIT_L(0); PG8_MMA(1, 0, At, B0); PG8_BAR; PG8_SCHED;
            PG8_STAGE(PG8_SB(0, 1), b2 + hstep, voffB);
            PG8_WAIT_V(6); PG8_BAR; PG8_MMA(1, 1, At, B1); PG8_BAR;
            PG8_LDB(B0, 1, 0); PG8_SCHED; PG8_LDA(At, 1, 0); PG8_STAGE(PG8_SA(0, 1), a2 + hstepA, voffA);
            PG8_WAIT_L(8); PG8_BAR; PG8_WAIT_L(0); PG8_MMA(0, 0, At, B0); PG8_BAR; PG8_SCHED;
            PG8_LDB(B1, 1, 1); PG8_STAGE(PG8_SB(1, 0), b3, voffB);
            PG8_BAR; PG8_WAIT_L(0); PG8_MMA(0, 1, At, B1); PG8_BAR;
            PG8_LDA(At, 1, 1); PG8_STAGE(PG8_SA(1, 0), a3, voffA);
            PG8_BAR; PG8_WAIT_L(0); PG8_MMA(1, 0, At, B0); PG8_BAR; PG8_SCHED;
            PG8_STAGE(PG8_SB(1, 1), b3 + hstep, voffB);
            PG8_WAIT_V(6); PG8_BAR; PG8_MMA(1, 1, At, B1); PG8_BAR;
            }
        }
        if constexpr (ALIGN_EPI) { if (wr == 0) PG8_BAR; }
        if constexpr (!Epi::AFTER_DRAIN) { E(acc, cur, wr, wc, fr, fq); S.done(cur); }
        if (!has_next) break;
#pragma unroll
        for (int a = 0; a < 2; ++a)
#pragma unroll
            for (int b = 0; b < 2; ++b)
#pragma unroll
                for (int m = 0; m < 4; ++m)
#pragma unroll
                    for (int n = 0; n < 2; ++n) acc[a][b][m][n] = (f32x4){0.f, 0.f, 0.f, 0.f};
        cur = nxt; cA = nA; cB = nB; ++ui;
        if constexpr (ALIGN_EPI) { if (wr == 1) PG8_BAR; }
    }
    PG8_WAIT_V(0);
    if constexpr (!ALIGN_EPI) { if (wr == 0) PG8_BAR; }
    PG8_BAR;
    if constexpr (Epi::AFTER_DRAIN) { E.fused(acc, cur, wr, wc, fr, fq, lds, wid, lane); S.done(cur); }
#undef PG8_SA
#undef PG8_SB
#undef PG8_STAGE
#undef PG8_LDA
#undef PG8_LDB
#undef PG8_MMA
#undef PG8_WAIT_V
#undef PG8_WAIT_L
#undef PG8_BAR
#undef PG8_SCHED
}
}

#define LAS __attribute__((address_space(3)))
using pg8::bf16_t; using pg8::bf16x8; using pg8::f32x4; using pg8::u32x4;
typedef float f32x16 __attribute__((ext_vector_type(16)));
typedef unsigned u32x2 __attribute__((ext_vector_type(2)));
typedef __bf16 bf2_t __attribute__((ext_vector_type(2)));
typedef float f32x2 __attribute__((ext_vector_type(2)));

constexpr int NB = 32, SEQ = 2048, DM = 1024, NTOK = NB * SEQ, NIN = 3328, DH = 512, NPROJ = 1792;
constexpr int PJ_GH = 0, PJ_Q = 512, PJ_K = 1024, PJ_V = 1152, PJ_GA = 1280;
constexpr float EPS = 1e-6f;
constexpr size_t WS_WIN = 0;
constexpr size_t WS_WOUT = WS_WIN + (size_t)NIN * DM * 2;
constexpr size_t WS_RF = WS_WOUT + (size_t)DM * DM * 2;
constexpr size_t WS_ROPE = WS_RF + (size_t)2 * DH * 4096 * 2;
constexpr size_t WS_XB = WS_ROPE + (size_t)SEQ * 32 * 4 * 2;
constexpr size_t WS_HYT = WS_XB + (size_t)NTOK * DM * 2;
constexpr size_t WS_PROJ = WS_HYT + (size_t)1536 * NTOK * 2;
constexpr size_t WS_ZT = WS_PROJ + (size_t)NTOK * NPROJ * 2;
constexpr size_t WS_YA = WS_ZT + (size_t)DH * NTOK * 2;
constexpr size_t WS_Y = WS_YA + (size_t)NTOK * DH * 2;
constexpr size_t WS_CTL = WS_Y + (size_t)NTOK * DM * 2;
constexpr size_t WS_END = WS_CTL + 4096;
constexpr int LDS_BYTES = 144 * 1024;
constexpr int NTHREADS = 512;
#ifndef GEMM_ALIGN
#define GEMM_ALIGN true
#endif
#ifndef GEMM_SP2
#define GEMM_SP2 true
#endif

#define LDS_WAIT() asm volatile("s_waitcnt lgkmcnt(0)" ::: "memory")
#define MFMA32(a, b, c) __builtin_amdgcn_mfma_f32_32x32x16_bf16((a), (b), (c), 0, 0, 0)

__device__ __forceinline__ unsigned pk2(float lo, float hi) { f32x2 v = {lo, hi}; bf2_t b = __builtin_convertvector(v, bf2_t); return __builtin_bit_cast(unsigned, b); }
__device__ __forceinline__ float bf_lo(unsigned w) { return __uint_as_float(w << 16); }
__device__ __forceinline__ float bf_hi(unsigned w) { return __uint_as_float(w & 0xffff0000u); }
__device__ __forceinline__ float bf1(bf16_t v) { return __uint_as_float(((unsigned)v) << 16); }
__device__ __forceinline__ float wave_sum(float v) {
#pragma unroll
    for (int o = 1; o < 64; o <<= 1) v += __shfl_xor(v, o);
    return v;
}

__device__ __forceinline__ float sin_acc(float x) { double r = (double)x * 0.15915494309189535; r -= rint(r); return __builtin_amdgcn_sinf((float)r); }
__device__ __forceinline__ float cos_acc(float x) { double r = (double)x * 0.15915494309189535; r -= rint(r); return __builtin_amdgcn_cosf((float)r); }
__device__ __forceinline__ float silu_f(float v) { return v * __builtin_amdgcn_rcpf(1.0f + __expf(-v)); }

struct EpiIn {
    static constexpr bool PERM = true, APERM = true, AFTER_DRAIN = false;
    bf16_t* hyt; bf16_t* proj;
    __device__ __forceinline__ void prefetch(const pg8::Unit&, int, float (&)[4]) const {}
    __device__ __forceinline__ void prefetch_done(float (&)[4]) const {}
    __device__ __forceinline__ void operator()(const f32x4 (&acc)[2][2][4][2], const pg8::Unit& u, int wr, int wc, int fr, int fq) const {
        const int tok0 = u.pm * 256 + wr * 128 + 8 * fr;
        if (u.pn < 6) {
            const int col0 = u.pn * 256 + wc * 32 + 8 * fq;
#pragma unroll
            for (int bj = 0; bj < 2; ++bj)
#pragma unroll
                for (int n = 0; n < 2; ++n)
#pragma unroll
                    for (int j = 0; j < 4; ++j) {
                        const int col = col0 + bj * 128 + 4 * n + j;
                        u32x4 w;
                        w.x = pk2(acc[0][bj][0][n][j], acc[0][bj][1][n][j]); w.y = pk2(acc[0][bj][2][n][j], acc[0][bj][3][n][j]);
                        w.z = pk2(acc[1][bj][0][n][j], acc[1][bj][1][n][j]); w.w = pk2(acc[1][bj][2][n][j], acc[1][bj][3][n][j]);
                        *(u32x4*)(hyt + (size_t)col * NTOK + tok0) = w;
                    }
        } else {
            const int pc0 = u.pn * 256 - 1536 + wc * 32 + 8 * fq;
#pragma unroll
            for (int ai = 0; ai < 2; ++ai)
#pragma unroll
                for (int m = 0; m < 4; ++m) {
                    bf16_t* rowp = proj + (size_t)(tok0 + 4 * ai + m) * NPROJ + pc0;
#pragma unroll
                    for (int bj = 0; bj < 2; ++bj) {
                        const f32x4 v0 = acc[ai][bj][m][0], v1 = acc[ai][bj][m][1];
                        u32x4 w; w.x = pk2(v0[0], v0[1]); w.y = pk2(v0[2], v0[3]); w.z = pk2(v1[0], v1[1]); w.w = pk2(v1[2], v1[3]);
                        *(u32x4*)(rowp + bj * 128) = w;
                    }
                }
        }
    }
};
struct EpiOut {
    static constexpr bool PERM = false, APERM = false, AFTER_DRAIN = false;
    const float* x; float* out;
    __device__ __forceinline__ void prefetch(const pg8::Unit& u, int tid, float (&pf)[4]) const {
#pragma unroll
        for (int i = 0; i < 4; ++i) { const int line = tid + 512 * i, r = line >> 3, c = (line & 7) * 32; pf[i] = x[(size_t)(u.pm * 256 + r) * DM + u.pn * 256 + c]; }
    }
    __device__ __forceinline__ void prefetch_done(float (&pf)[4]) const { asm volatile("" :: "v"(pf[0]), "v"(pf[1]), "v"(pf[2]), "v"(pf[3])); }
    __device__ __forceinline__ void operator()(const f32x4 (&acc)[2][2][4][2], const pg8::Unit& u, int wr, int wc, int fr, int fq) const {
        const int row0 = u.pm * 256 + wr * 64 + fr, col0 = u.pn * 256 + wc * 32 + 4 * fq;
        const float* xb = x + (size_t)row0 * DM + col0; float* ob = out + (size_t)row0 * DM + col0;
#pragma unroll
        for (int ai = 0; ai < 2; ++ai)
#pragma unroll
            for (int mp = 0; mp < 2; ++mp) {
                f32x4 xv[2][2][2];
#pragma unroll
                for (int mm = 0; mm < 2; ++mm)
#pragma unroll
                    for (int bj = 0; bj < 2; ++bj)
#pragma unroll
                        for (int n = 0; n < 2; ++n) xv[mm][bj][n] = *(const f32x4*)(xb + (size_t)(ai * 128 + (2 * mp + mm) * 16) * DM + bj * 128 + n * 16);
                __builtin_amdgcn_sched_barrier(0);
#pragma unroll
                for (int mm = 0; mm < 2; ++mm)
#pragma unroll
                    for (int bj = 0; bj < 2; ++bj)
#pragma unroll
                        for (int n = 0; n < 2; ++n) *(f32x4*)(ob + (size_t)(ai * 128 + (2 * mp + mm) * 16) * DM + bj * 128 + n * 16) = xv[mm][bj][n] + acc[ai][bj][2 * mp + mm][n];
                __builtin_amdgcn_sched_barrier(0);
            }
    }
};

__device__ __forceinline__ void p0_transpose_item(const float* W, const float* gk, int K, int N, bf16_t* WT, LAS float* scr, int item, int lane) {
    const int nblk = N / 32, kb = item / nblk, nb = item % nblk, k0 = 64 * kb, n0 = 32 * nb;
#pragma unroll 8
    for (int i = 0; i < 32; ++i) { const int kk = 2 * i + (lane >> 5); scr[kk * 33 + (lane & 31)] = W[(size_t)(k0 + kk) * N + n0 + (lane & 31)] * gk[k0 + kk]; }
    LDS_WAIT();
    const int c = lane & 7;
#pragma unroll
    for (int j = 0; j < 4; ++j) {
        const int n = (lane >> 3) + 8 * j; const LAS float* s = scr + (8 * c) * 33 + n;
        u32x4 o; o.x = pk2(s[0 * 33], s[1 * 33]); o.y = pk2(s[2 * 33], s[3 * 33]); o.z = pk2(s[4 * 33], s[5 * 33]); o.w = pk2(s[6 * 33], s[7 * 33]);
        *(u32x4*)(WT + (size_t)(n0 + n) * K + k0 + 8 * c) = o;
    }
    LDS_WAIT();
}

struct Params { const float* in[20]; float* out; unsigned char* ws; };

__device__ __forceinline__ void p0_prologue(const Params& p, LAS unsigned char* lds, int tid, int wave, int lane) {
    LAS float* scr = (LAS float*)(lds + wave * 16384);
    const int gw = blockIdx.x * 8 + wave, NGW = gridDim.x * 8;
    bf16_t* WinT = (bf16_t*)(p.ws + WS_WIN); bf16_t* WoutT = (bf16_t*)(p.ws + WS_WOUT); bf16_t* RF = (bf16_t*)(p.ws + WS_RF);
    float* ROPE = (float*)(p.ws + WS_ROPE); bf16_t* XB = (bf16_t*)(p.ws + WS_XB);
    constexpr int I_IN = (DM / 64) * (NIN / 32);
#pragma unroll 1
    for (int it = gw; it < I_IN; it += NGW) p0_transpose_item(p.in[2], p.in[1], DM, NIN, WinT, scr, it, lane);
    __syncthreads();
    {
        const float* w1 = p.in[5]; const float* b1 = p.in[6]; const float* w2 = p.in[7]; const float* b2 = p.in[8];
        const float* w3 = p.in[9]; const float* b3 = p.in[10]; const float* w4 = p.in[11]; const float* sf = p.in[12];
        const float* hbias = p.in[13];
#pragma unroll 1
        for (int l = gw; l < SEQ; l += NGW) {
            const float t = (float)l / 2047.0f;
            const float w = 6.283185307179586f * (float)l / 2048.0f;
            if (lane < 33) {
                float zi;
                if (lane == 0) zi = t;
                else { const int i = (lane - 1) & 15; const float f = 1e-4f + (float)i * ((15.0f - 1e-4f) / 15.0f); const float a = f * w; zi = (lane <= 16) ? cos_acc(a) : -sin_acc(a); }
                scr[lane] = zi;
            }
            LDS_WAIT();
            const float fr = sf[lane];
            float a = b1[lane];
#pragma unroll 11
            for (int i = 0; i < 33; ++i) a += scr[i] * w1[i * 64 + lane];
            scr[64 + lane] = sin_acc(fr * a);
            LDS_WAIT();
            a = b2[lane];
#pragma unroll 16
            for (int i = 0; i < 64; ++i) a += scr[64 + i] * w2[i * 64 + lane];
            scr[128 + lane] = sin_acc(fr * a);
            LDS_WAIT();
            a = b3[lane];
#pragma unroll 16
            for (int i = 0; i < 64; ++i) a += scr[128 + i] * w3[i * 64 + lane];
            scr[192 + lane] = sin_acc(fr * a);
            LDS_WAIT();
            {
                f32x4 acc4[8];
#pragma unroll
                for (int i = 0; i < 8; ++i) acc4[i] = (f32x4){0.f, 0.f, 0.f, 0.f};
                const f32x4* w4v = (const f32x4*)w4;
                f32x4 stg[8];
#pragma unroll
                for (int q = 0; q < 8; ++q) stg[q] = w4v[tid + 512 * q];
#pragma unroll 1
                for (int jc = 0; jc < 64; jc += 8) {
                    __syncthreads();
#pragma unroll
                    for (int q = 0; q < 8; ++q) { const int idx = tid + 512 * q; *(LAS f32x4*)(lds + (idx >> 9) * 16384 + 8192 + (idx & 511) * 16) = stg[q]; }
                    if (jc + 8 < 64) {
#pragma unroll
                        for (int q = 0; q < 8; ++q) stg[q] = w4v[(jc + 8) * 512 + tid + 512 * q];
                    }
                    __syncthreads();
#pragma unroll
                    for (int jj = 0; jj < 8; ++jj) {
                        const float hj = scr[192 + jc + jj];
                        const LAS f32x4* wr4 = (const LAS f32x4*)(lds + jj * 16384 + 8192) + lane;
#pragma unroll
                        for (int i = 0; i < 8; ++i) acc4[i] += hj * wr4[64 * i];
                    }
                }
#pragma unroll
                for (int i = 0; i < 8; ++i) {
                    float val[4];
#pragma unroll
                    for (int e = 0; e < 4; ++e) {
                        const int n = 4 * lane + 256 * i + e;
                        const int o = n >> 10, dir = (n >> 9) & 1, c = n & 511;
                        const float ad = 3.0701134573f + (float)c * ((15.3505672866f - 3.0701134573f) / 511.0f);
                        val[e] = acc4[i][e] * __expf(-t * ad);
                        if (l == 0 && dir == 0) val[e] += hbias[o * 512 + c];
                    }
                    u32x2 w; w.x = pk2(val[0], val[1]); w.y = pk2(val[2], val[3]);
                    *(u32x2*)(RF + (size_t)l * 2048 + 4 * lane + 256 * i) = w;
                }
            }
            LDS_WAIT();
        }
    }
    for (int idx = blockIdx.x * NTHREADS + tid; idx < SEQ * 32; idx += gridDim.x * NTHREADS) {
        const int pos = idx >> 5, i = idx & 31;
        const float inv = exp2f(-(float)i * (13.287712379549449f / 32.0f));
        const float ang = (float)pos * inv;
        ROPE[idx] = cos_acc(ang); ROPE[SEQ * 32 + idx] = sin_acc(ang);
    }
    {
        const float* x = p.in[0];
#pragma unroll 1
        for (int m = gw; m < NTOK; m += 2 * NGW) {
            const int m2 = m + NGW;
            const bool has2 = m2 < NTOK;
            const f32x4* xr = (const f32x4*)(x + (size_t)m * DM) + lane;
            const f32x4* xr2 = (const f32x4*)(x + (size_t)(has2 ? m2 : m) * DM) + lane;
            f32x4 v[4], v2[4]; float s = 0.f, s2 = 0.f;
#pragma unroll
            for (int j = 0; j < 4; ++j) { v[j] = __builtin_nontemporal_load(xr + 64 * j); v2[j] = __builtin_nontemporal_load(xr2 + 64 * j); }
#pragma unroll
            for (int j = 0; j < 4; ++j) { s += (v[j].x * v[j].x + v[j].y * v[j].y) + (v[j].z * v[j].z + v[j].w * v[j].w); s2 += (v2[j].x * v2[j].x + v2[j].y * v2[j].y) + (v2[j].z * v2[j].z + v2[j].w * v2[j].w); }
            const float rstd = 1.0f / sqrtf(wave_sum(s) * (1.0f / DM) + EPS), rstd2 = 1.0f / sqrtf(wave_sum(s2) * (1.0f / DM) + EPS);
            u32x2* o8 = (u32x2*)(XB + (size_t)m * DM) + lane;
#pragma unroll
            for (int j = 0; j < 4; ++j) { u32x2 w; w.x = pk2(v[j].x * rstd, v[j].y * rstd); w.y = pk2(v[j].z * rstd, v[j].w * rstd); o8[64 * j] = w; }
            if (has2) {
                u32x2* o82 = (u32x2*)(XB + (size_t)m2 * DM) + lane;
#pragma unroll
                for (int j = 0; j < 4; ++j) { u32x2 w; w.x = pk2(v2[j].x * rstd2, v2[j].y * rstd2); w.y = pk2(v2[j].z * rstd2, v2[j].w * rstd2); o82[64 * j] = w; }
            }
        }
    }
}

constexpr int UROWB = 4112;
constexpr int HY_R_OFF = 32 * UROWB;

__device__ __forceinline__ bf16x8 load_afrag(const LAS unsigned* Rw, int n0) {
    const int dw = n0 >> 1; const unsigned sh = (unsigned)(n0 & 1) << 4;
    const unsigned d0 = Rw[dw], d1 = Rw[dw + 1], d2 = Rw[dw + 2], d3 = Rw[dw + 3], d4 = Rw[dw + 4];
    u32x4 f;
    f.x = __builtin_amdgcn_alignbit(d1, d0, sh); f.y = __builtin_amdgcn_alignbit(d2, d1, sh);
    f.z = __builtin_amdgcn_alignbit(d3, d2, sh); f.w = __builtin_amdgcn_alignbit(d4, d3, sh);
    return __builtin_bit_cast(bf16x8, f);
}
__device__ __forceinline__ void hy_conv(f32x16 (&acc)[8], const LAS unsigned char* lds, int wave, int i32, int h) {
    const LAS unsigned* Rw = (const LAS unsigned*)(lds + HY_R_OFF);
    const LAS unsigned char* Ub = lds + i32 * UROWB + 16 * h;
    const int nbase = 2048 - 256 * wave - i32 + 8 * h;
    bf16x8 AE[8], AO[8];
#pragma unroll
    for (int r = 0; r < 8; ++r) {
#pragma unroll
        for (int i = 0; i < 16; ++i) acc[r][i] = 0.f;
        AE[r] = load_afrag(Rw, nbase - 32 * r); AO[r] = load_afrag(Rw, nbase - 32 * r + 16);
    }
    for (int P = 0; P < 8; ++P) {
#pragma unroll
        for (int p = 0; p < 8; ++p) {
            const int S = 8 * P + p;
            const bf16x8 Be = *(const LAS bf16x8*)(Ub + 64 * S), Bo = *(const LAS bf16x8*)(Ub + 64 * S + 32);
#pragma unroll
            for (int r = 0; r < 8; ++r) {
                acc[r] = MFMA32(AE[(r - p) & 7], Be, acc[r]);
                acc[r] = MFMA32(AO[(r - p) & 7], Bo, acc[r]);
            }
            if (S + 1 < 64) { AE[(7 - p) & 7] = load_afrag(Rw, nbase + 32 * (S + 1)); AO[(7 - p) & 7] = load_afrag(Rw, nbase + 32 * (S + 1) + 16); }
        }
    }
}

__device__ __forceinline__ void hy_stage(LAS unsigned char* lds, const bf16_t* hy, float w0, float w1, float w2, float bias, int tid) {
#pragma unroll 4
    for (int ch = tid; ch < 8192; ch += NTHREADS) {
        const int b = ch >> 8, t0 = (ch & 255) << 3; const bf16_t* row = hy + b * SEQ;
        const u32x4 v = *(const u32x4*)(row + t0);
        float x[10];
        x[0] = bf1(row[(t0 > 0) ? t0 - 1 : 0]); x[9] = bf1(row[(t0 + 8 < SEQ) ? t0 + 8 : SEQ - 1]);
        x[0] = (t0 > 0) ? x[0] : 0.f; x[9] = (t0 + 8 < SEQ) ? x[9] : 0.f;
        x[1] = bf_lo(v.x); x[2] = bf_hi(v.x); x[3] = bf_lo(v.y); x[4] = bf_hi(v.y); x[5] = bf_lo(v.z); x[6] = bf_hi(v.z); x[7] = bf_lo(v.w); x[8] = bf_hi(v.w);
        float o[8];
#pragma unroll
        for (int j = 0; j < 8; ++j) o[j] = bias + w0 * x[j] + w1 * x[j + 1] + w2 * x[j + 2];
        u32x4 w; w.x = pk2(o[0], o[1]); w.y = pk2(o[2], o[3]); w.z = pk2(o[4], o[5]); w.w = pk2(o[6], o[7]);
        *(LAS u32x4*)(lds + b * UROWB + t0 * 2) = w;
    }
}
__device__ __forceinline__ void hy_gate_inplace(LAS unsigned char* lds, const f32x16 (&acc)[8], int wave, int i32, int h) {
    LAS unsigned char* lp = lds + i32 * UROWB + (256 * wave + 4 * h) * 2;
#pragma unroll
    for (int r = 0; r < 8; ++r)
#pragma unroll
        for (int g = 0; g < 4; ++g) {
            LAS u32x2* up = (LAS u32x2*)(lp + (32 * r + 8 * g) * 2);
            const u32x2 uu = *up;
            u32x2 w; w.x = pk2(bf_lo(uu.x) * acc[r][4 * g + 0], bf_hi(uu.x) * acc[r][4 * g + 1]); w.y = pk2(bf_lo(uu.y) * acc[r][4 * g + 2], bf_hi(uu.y) * acc[r][4 * g + 3]);
            *up = w;
        }
}
__device__ __forceinline__ void hy_load_filter(LAS unsigned char* lds, const bf16_t* RF, int o, int c, int tid) {
    unsigned v[8];
#pragma unroll
    for (int j = 0; j < 8; ++j) {
        const int n = 8 * tid + j;
        const int dir = (n > 2048) ? 1 : 0, l = (n > 2048) ? n - 2048 : 2048 - n;
        const int ll = (l > 2047) ? 2047 : l;
        v[j] = RF[(size_t)ll * 2048 + (o * 2 + dir) * 512 + c];
        if (n == 0) v[j] = 0u;
    }
    u32x4 w; w.x = v[0] | (v[1] << 16); w.y = v[2] | (v[3] << 16); w.z = v[4] | (v[5] << 16); w.w = v[6] | (v[7] << 16);
    *(LAS u32x4*)(lds + HY_R_OFF + tid * 16) = w;
}
__device__ __forceinline__ void hyena_unit(const Params& p, LAS unsigned char* lds, int c, int tid, int wave, int lane) {
    const bf16_t* HYT = (const bf16_t*)(p.ws + WS_HYT); const bf16_t* RF = (const bf16_t*)(p.ws + WS_RF); bf16_t* ZT = (bf16_t*)(p.ws + WS_ZT);
    const float* cw = p.in[3]; const float* cb = p.in[4];
    asm volatile("" : "+v"(tid), "+v"(lane));
    int i32 = lane & 31, h = lane >> 5;
    hy_stage(lds, HYT + (size_t)c * NTOK, cw[c], cw[1536 + c], cw[3072 + c], cb[c], tid);
    hy_load_filter(lds, RF, 0, c, tid);
    if (tid < 4) *(LAS unsigned*)(lds + HY_R_OFF + 8192 + tid * 4) = 0u;
    __syncthreads();
    f32x16 acc[8];
    hy_conv(acc, lds, wave, i32, h);
    __syncthreads();
    asm volatile("" : "+v"(tid), "+v"(i32), "+v"(h));
    hy_stage(lds, HYT + (size_t)(512 + c) * NTOK, cw[512 + c], cw[1536 + 512 + c], cw[3072 + 512 + c], cb[512 + c], tid);
    hy_load_filter(lds, RF, 1, c, tid);
    __syncthreads();
    hy_gate_inplace(lds, acc, wave, i32, h);
    __syncthreads();
    hy_conv(acc, lds, wave, i32, h);
    __syncthreads();
    asm volatile("" : "+v"(tid), "+v"(i32), "+v"(h));
    hy_stage(lds, HYT + (size_t)(1024 + c) * NTOK, cw[1024 + c], cw[1536 + 1024 + c], cw[3072 + 1024 + c], cb[1024 + c], tid);
    __syncthreads();
    hy_gate_inplace(lds, acc, wave, i32, h);
    __syncthreads();
    {
        bf16_t* zt = ZT + (size_t)c * NTOK;
#pragma unroll 4
        for (int ch = tid; ch < 8192; ch += NTHREADS) {
            const int b = ch >> 8, t0 = (ch & 255) << 3;
            *(u32x4*)(zt + b * SEQ + t0) = *(const LAS u32x4*)(lds + b * UROWB + t0 * 2);
        }
    }
    __syncthreads();
}

constexpr int KROWB = 144;
constexpr int VROWB = 792;
constexpr int AT_V_OFF = 384 * KROWB;

__device__ __forceinline__ void attn_unit(const Params& p, LAS unsigned char* lds, int unit, int tid, int wave, int lane) {
    const bf16_t* proj = (const bf16_t*)(p.ws + WS_PROJ); const float* ROPE = (const float*)(p.ws + WS_ROPE); bf16_t* YA = (bf16_t*)(p.ws + WS_YA);
    const float* qg = p.in[14]; const float* kg = p.in[15]; const float* sink = p.in[16];
    const int b = unit >> 4, start = (unit & 15) * 128;
    asm volatile("" : "+v"(tid), "+v"(lane));
    const int i32 = lane & 31, h = lane >> 5;
    const float* RC = ROPE; const float* RS = ROPE + SEQ * 32;
    for (int kvh = 0; kvh < 2; ++kvh) {
#pragma unroll
        for (int task = tid; task < 1536; task += NTHREADS) {
            const int kk = task >> 2, c4 = task & 3, kp = start - 128 + kk;
            const bool valid = (kp >= 0) && (kp < SEQ);
            float x1[8], x2[8]; float ss = 0.f;
            if (valid) {
                const bf16_t* src = proj + (size_t)(b * SEQ + kp) * NPROJ + PJ_K + kvh * 64 + 8 * c4;
                const u32x4 a = *(const u32x4*)src, bq = *(const u32x4*)(src + 32);
                x1[0] = bf_lo(a.x); x1[1] = bf_hi(a.x); x1[2] = bf_lo(a.y); x1[3] = bf_hi(a.y); x1[4] = bf_lo(a.z); x1[5] = bf_hi(a.z); x1[6] = bf_lo(a.w); x1[7] = bf_hi(a.w);
                x2[0] = bf_lo(bq.x); x2[1] = bf_hi(bq.x); x2[2] = bf_lo(bq.y); x2[3] = bf_hi(bq.y); x2[4] = bf_lo(bq.z); x2[5] = bf_hi(bq.z); x2[6] = bf_lo(bq.w); x2[7] = bf_hi(bq.w);
#pragma unroll
                for (int j = 0; j < 8; ++j) ss += x1[j] * x1[j] + x2[j] * x2[j];
            } else {
#pragma unroll
                for (int j = 0; j < 8; ++j) { x1[j] = 0.f; x2[j] = 0.f; }
            }
            ss += __shfl_xor(ss, 1); ss += __shfl_xor(ss, 2);
            u32x4 o1 = {0u, 0u, 0u, 0u}, o2 = {0u, 0u, 0u, 0u};
            if (valid) {
                const float rstd = 1.0f / sqrtf(ss * (1.0f / 64.0f) + EPS);
                const f32x4 c0 = *(const f32x4*)(RC + kp * 32 + 8 * c4), c1 = *(const f32x4*)(RC + kp * 32 + 8 * c4 + 4);
                const f32x4 s0 = *(const f32x4*)(RS + kp * 32 + 8 * c4), s1 = *(const f32x4*)(RS + kp * 32 + 8 * c4 + 4);
                float r1[8], r2[8];
#pragma unroll
                for (int j = 0; j < 8; ++j) {
                    const float cc = (j < 4) ? c0[j & 3] : c1[j & 3], sn = (j < 4) ? s0[j & 3] : s1[j & 3];
                    const float a1 = x1[j] * rstd * kg[8 * c4 + j], a2 = x2[j] * rstd * kg[32 + 8 * c4 + j];
                    r1[j] = a1 * cc - a2 * sn; r2[j] = a2 * cc + a1 * sn;
                }
                o1.x = pk2(r1[0], r1[1]); o1.y = pk2(r1[2], r1[3]); o1.z = pk2(r1[4], r1[5]); o1.w = pk2(r1[6], r1[7]);
                o2.x = pk2(r2[0], r2[1]); o2.y = pk2(r2[2], r2[3]); o2.z = pk2(r2[4], r2[5]); o2.w = pk2(r2[6], r2[7]);
            }
            *(LAS u32x4*)(lds + kk * KROWB + 16 * c4) = o1;
            *(LAS u32x4*)(lds + kk * KROWB + 64 + 16 * c4) = o2;
        }
#pragma unroll
        for (int task = tid; task < 3072; task += NTHREADS) {
            const int kk = task >> 3, c8 = task & 7, kp = start - 128 + kk;
            u32x4 v = {0u, 0u, 0u, 0u};
            if (kp >= 0 && kp < SEQ) v = *(const u32x4*)(proj + (size_t)(b * SEQ + kp) * NPROJ + PJ_V + kvh * 64 + 8 * c8);
            LAS unsigned char* dst = lds + AT_V_OFF + (8 * c8) * VROWB + kk * 2;
            *(LAS bf16_t*)(dst + 0 * VROWB) = (bf16_t)(v.x & 0xffffu); *(LAS bf16_t*)(dst + 1 * VROWB) = (bf16_t)(v.x >> 16);
            *(LAS bf16_t*)(dst + 2 * VROWB) = (bf16_t)(v.y & 0xffffu); *(LAS bf16_t*)(dst + 3 * VROWB) = (bf16_t)(v.y >> 16);
            *(LAS bf16_t*)(dst + 4 * VROWB) = (bf16_t)(v.z & 0xffffu); *(LAS bf16_t*)(dst + 5 * VROWB) = (bf16_t)(v.z >> 16);
            *(LAS bf16_t*)(dst + 6 * VROWB) = (bf16_t)(v.w & 0xffffu); *(LAS bf16_t*)(dst + 7 * VROWB) = (bf16_t)(v.w >> 16);
        }
        const int g = wave >> 1, half = wave & 1, hq = kvh * 4 + g, p0 = start + 64 * half;
        u32x4 qraw[2][4];
#pragma unroll
        for (int qt = 0; qt < 2; ++qt) {
            const bf16_t* src = proj + (size_t)(b * SEQ + p0 + 32 * qt + i32) * NPROJ + PJ_Q + hq * 64 + 8 * h;
#pragma unroll
            for (int ks = 0; ks < 4; ++ks) qraw[qt][ks] = *(const u32x4*)(src + 16 * ks);
        }
        __syncthreads();
        bf16x8 qf[2][4];
#pragma unroll
        for (int qt = 0; qt < 2; ++qt) {
            const int pos = p0 + 32 * qt + i32;
            float x[4][8]; float ss = 0.f;
#pragma unroll
            for (int ks = 0; ks < 4; ++ks) {
                const u32x4 a = qraw[qt][ks];
                x[ks][0] = bf_lo(a.x); x[ks][1] = bf_hi(a.x); x[ks][2] = bf_lo(a.y); x[ks][3] = bf_hi(a.y); x[ks][4] = bf_lo(a.z); x[ks][5] = bf_hi(a.z); x[ks][6] = bf_lo(a.w); x[ks][7] = bf_hi(a.w);
#pragma unroll
                for (int j = 0; j < 8; ++j) ss += x[ks][j] * x[ks][j];
            }
            ss += __shfl_xor(ss, 32);
            const float rstd = (0.125f * 1.4426950408889634f) / sqrtf(ss * (1.0f / 64.0f) + EPS);
#pragma unroll
            for (int ks = 0; ks < 2; ++ks) {
                const int d1 = 16 * ks + 8 * h;
                const f32x4 c0 = *(const f32x4*)(RC + pos * 32 + d1), c1 = *(const f32x4*)(RC + pos * 32 + d1 + 4);
                const f32x4 s0 = *(const f32x4*)(RS + pos * 32 + d1), s1 = *(const f32x4*)(RS + pos * 32 + d1 + 4);
#pragma unroll
                for (int j = 0; j < 8; ++j) {
                    const float cc = (j < 4) ? c0[j & 3] : c1[j & 3], sn = (j < 4) ? s0[j & 3] : s1[j & 3];
                    const float a1 = x[ks][j] * rstd * qg[d1 + j], a2 = x[ks + 2][j] * rstd * qg[d1 + 32 + j];
                    x[ks][j] = a1 * cc - a2 * sn; x[ks + 2][j] = a2 * cc + a1 * sn;
                }
            }
#pragma unroll
            for (int ks = 0; ks < 4; ++ks) {
                u32x4 w; w.x = pk2(x[ks][0], x[ks][1]); w.y = pk2(x[ks][2], x[ks][3]); w.z = pk2(x[ks][4], x[ks][5]); w.w = pk2(x[ks][6], x[ks][7]);
                qf[qt][ks] = __builtin_bit_cast(bf16x8, w);
            }
        }
        const float sink2 = sink[hq] * 1.4426950408889634f;
        float mrun[2] = {sink2, sink2}, lrun[2] = {1.0f, 1.0f};
        f32x16 o[2][2];
#pragma unroll
        for (int a = 0; a < 2; ++a)
#pragma unroll
            for (int c = 0; c < 2; ++c)
#pragma unroll
                for (int i = 0; i < 16; ++i) o[a][c][i] = 0.f;
        for (int jt = 0; jt < 5; ++jt) {
            const int kk0 = 64 * half + 64 * jt, kp0 = start - 128 + kk0;
            if (kp0 + 63 < 0 || kp0 >= SEQ) continue;
            const bool need_mask = (jt == 0) || (jt == 4) || (kp0 < 0) || (kp0 + 64 > SEQ);
            f32x16 st[2][2];
#pragma unroll
            for (int a = 0; a < 2; ++a)
#pragma unroll
                for (int c = 0; c < 2; ++c)
#pragma unroll
                    for (int i = 0; i < 16; ++i) st[a][c][i] = 0.f;
#pragma unroll
            for (int ks = 0; ks < 4; ++ks) {
                const bf16x8 kf0 = *(const LAS bf16x8*)(lds + (kk0 + i32) * KROWB + (16 * ks + 8 * h) * 2);
                const bf16x8 kf1 = *(const LAS bf16x8*)(lds + (kk0 + 32 + i32) * KROWB + (16 * ks + 8 * h) * 2);
#pragma unroll
                for (int qt = 0; qt < 2; ++qt) { st[0][qt] = MFMA32(kf0, qf[qt][ks], st[0][qt]); st[1][qt] = MFMA32(kf1, qf[qt][ks], st[1][qt]); }
            }
#pragma unroll
            for (int qt = 0; qt < 2; ++qt) {
                const int qpos = p0 + 32 * qt + i32;
                float mx = -INFINITY;
#pragma unroll
                for (int mt = 0; mt < 2; ++mt)
#pragma unroll
                    for (int i = 0; i < 16; ++i) {
                        float s = st[mt][qt][i];
                        if (need_mask) {
                            const int kp = kp0 + 32 * mt + (i & 3) + 8 * (i >> 2) + 4 * h;
                            const int dlt = kp - qpos;
                            const bool ok = (kp >= 0) && (kp < SEQ) && (dlt <= 128) && (dlt >= -128);
                            s = ok ? s : -INFINITY;
                            st[mt][qt][i] = s;
                        }
                        mx = fmaxf(mx, s);
                    }
                mx = fmaxf(mx, __shfl_xor(mx, 32));
                const float mnew = fmaxf(mrun[qt], mx);
                const float alpha = __builtin_amdgcn_exp2f(mrun[qt] - mnew);
                mrun[qt] = mnew;
                float rs = 0.f;
#pragma unroll
                for (int mt = 0; mt < 2; ++mt)
#pragma unroll
                    for (int i = 0; i < 16; ++i) { const float pv = __builtin_amdgcn_exp2f(st[mt][qt][i] - mnew); st[mt][qt][i] = pv; rs += pv; }
                rs += __shfl_xor(rs, 32);
                lrun[qt] = lrun[qt] * alpha + rs;
#pragma unroll
                for (int i = 0; i < 16; ++i) { o[0][qt][i] *= alpha; o[1][qt][i] *= alpha; }
            }
#pragma unroll
            for (int mt = 0; mt < 2; ++mt)
#pragma unroll
                for (int s2 = 0; s2 < 2; ++s2) {
                    bf16x8 pf[2];
#pragma unroll
                    for (int qt = 0; qt < 2; ++qt) {
                        u32x4 w; w.x = pk2(st[mt][qt][8 * s2 + 0], st[mt][qt][8 * s2 + 1]); w.y = pk2(st[mt][qt][8 * s2 + 2], st[mt][qt][8 * s2 + 3]);
                        w.z = pk2(st[mt][qt][8 * s2 + 4], st[mt][qt][8 * s2 + 5]); w.w = pk2(st[mt][qt][8 * s2 + 6], st[mt][qt][8 * s2 + 7]);
                        pf[qt] = __builtin_bit_cast(bf16x8, w);
                    }
                    const int kb = kk0 + 32 * mt + 16 * s2 + 4 * h;
#pragma unroll
                    for (int dt = 0; dt < 2; ++dt) {
                        const LAS unsigned char* vp = lds + AT_V_OFF + (32 * dt + i32) * VROWB + kb * 2;
                        const u32x2 lo = *(const LAS u32x2*)vp, hi = *(const LAS u32x2*)(vp + 16);
                        u32x4 w; w.x = lo.x; w.y = lo.y; w.z = hi.x; w.w = hi.y;
                        const bf16x8 vf = __builtin_bit_cast(bf16x8, w);
#pragma unroll
                        for (int qt = 0; qt < 2; ++qt) o[dt][qt] = MFMA32(vf, pf[qt], o[dt][qt]);
                    }
                }
        }
#pragma unroll
        for (int qt = 0; qt < 2; ++qt) {
            const float inv = 1.0f / lrun[qt];
            bf16_t* dst = YA + (size_t)(b * SEQ + p0 + 32 * qt + i32) * DH + hq * 64 + 4 * h;
#pragma unroll
            for (int dt = 0; dt < 2; ++dt)
#pragma unroll
                for (int g4 = 0; g4 < 4; ++g4) {
                    u32x2 w; w.x = pk2(o[dt][qt][4 * g4 + 0] * inv, o[dt][qt][4 * g4 + 1] * inv); w.y = pk2(o[dt][qt][4 * g4 + 2] * inv, o[dt][qt][4 * g4 + 3] * inv);
                    *(u32x2*)(dst + 32 * dt + 8 * g4) = w;
                }
        }
        __syncthreads();
    }
}

constexpr int TROWB = 1028;
__device__ __forceinline__ void p3_unit(const Params& p, LAS unsigned char* lds, int unit, int tid, int wave, int lane) {
    const bf16_t* ZT = (const bf16_t*)(p.ws + WS_ZT); const bf16_t* YA = (const bf16_t*)(p.ws + WS_YA); const bf16_t* proj = (const bf16_t*)(p.ws + WS_PROJ);
    bf16_t* Y = (bf16_t*)(p.ws + WS_Y);
    const int tok0 = unit * 64;
#pragma unroll 4
    for (int task = tid; task < 4096; task += NTHREADS) {
        const int c = task >> 3, ch = task & 7;
        const u32x4 v = *(const u32x4*)(ZT + (size_t)c * NTOK + tok0 + 8 * ch);
        LAS unsigned char* dst = lds + (8 * ch) * TROWB + 2 * c;
        *(LAS bf16_t*)(dst + 0 * TROWB) = (bf16_t)(v.x & 0xffffu); *(LAS bf16_t*)(dst + 1 * TROWB) = (bf16_t)(v.x >> 16);
        *(LAS bf16_t*)(dst + 2 * TROWB) = (bf16_t)(v.y & 0xffffu); *(LAS bf16_t*)(dst + 3 * TROWB) = (bf16_t)(v.y >> 16);
        *(LAS bf16_t*)(dst + 4 * TROWB) = (bf16_t)(v.z & 0xffffu); *(LAS bf16_t*)(dst + 5 * TROWB) = (bf16_t)(v.z >> 16);
        *(LAS bf16_t*)(dst + 6 * TROWB) = (bf16_t)(v.w & 0xffffu); *(LAS bf16_t*)(dst + 7 * TROWB) = (bf16_t)(v.w >> 16);
    }
    __syncthreads();
    for (int half = 0; half < 2; ++half) {
        unsigned zh[4][4], gh4[4][4], za[4][4], ga4[4][4];
#pragma unroll
        for (int q = 0; q < 4; ++q) {
            const int tt = wave + 8 * (4 * half + q); const size_t token = (size_t)(tok0 + tt);
            const LAS unsigned* rw = (const LAS unsigned*)(lds + tt * TROWB);
            const unsigned* gh = (const unsigned*)(proj + token * NPROJ + PJ_GH); const unsigned* ga = (const unsigned*)(proj + token * NPROJ + PJ_GA);
            const unsigned* ya = (const unsigned*)(YA + token * DH);
#pragma unroll
            for (int k = 0; k < 4; ++k) { zh[q][k] = rw[lane + 64 * k]; gh4[q][k] = gh[lane + 64 * k]; za[q][k] = ya[lane + 64 * k]; ga4[q][k] = ga[lane + 64 * k]; }
        }
#pragma unroll
        for (int q = 0; q < 4; ++q) {
            const int tt = wave + 8 * (4 * half + q); const size_t token = (size_t)(tok0 + tt);
            float ssh = 0.f, ssa = 0.f;
#pragma unroll
            for (int k = 0; k < 4; ++k) { const float a = bf_lo(zh[q][k]), bq = bf_hi(zh[q][k]), c2 = bf_lo(za[q][k]), d2 = bf_hi(za[q][k]); ssh += a * a + bq * bq; ssa += c2 * c2 + d2 * d2; }
            const float rh = 1.0f / sqrtf(wave_sum(ssh) * (1.0f / 512.0f) + EPS), ra = 1.0f / sqrtf(wave_sum(ssa) * (1.0f / 512.0f) + EPS);
            unsigned* yo = (unsigned*)(Y + token * DM);
#pragma unroll
            for (int k = 0; k < 4; ++k) {
                yo[lane + 64 * k] = pk2(bf_lo(zh[q][k]) * rh * silu_f(bf_lo(gh4[q][k])), bf_hi(zh[q][k]) * rh * silu_f(bf_hi(gh4[q][k])));
                yo[256 + lane + 64 * k] = pk2(bf_lo(za[q][k]) * ra * silu_f(bf_lo(ga4[q][k])), bf_hi(za[q][k]) * ra * silu_f(bf_hi(ga4[q][k])));
            }
        }
    }
    __syncthreads();
}

__device__ __forceinline__ void grid_bar(unsigned* ctr, unsigned target) {
    asm volatile("s_waitcnt vmcnt(0) lgkmcnt(0)" ::: "memory");
    __syncthreads();
    if (threadIdx.x == 0) {
        __builtin_amdgcn_fence(__ATOMIC_RELEASE, "agent");
        asm volatile("s_waitcnt vmcnt(0)" ::: "memory");
        __hip_atomic_fetch_add(ctr, 1u, __ATOMIC_RELAXED, __HIP_MEMORY_SCOPE_AGENT);
        while (__hip_atomic_load(ctr, __ATOMIC_RELAXED, __HIP_MEMORY_SCOPE_AGENT) < target) __builtin_amdgcn_s_sleep(1);
        __builtin_amdgcn_fence(__ATOMIC_ACQUIRE, "agent");
        asm volatile("s_waitcnt vmcnt(0)" ::: "memory");
    }
    __syncthreads();
}

__global__ void __launch_bounds__(NTHREADS) hymba_fwd(Params p) {
    extern __shared__ __attribute__((aligned(16))) unsigned char lds_raw[];
    LAS unsigned char* lds = (LAS unsigned char*)lds_raw;
    cg::grid_group grid = cg::this_grid();
    unsigned* ctl = (unsigned*)(p.ws + WS_CTL);
    int tid = threadIdx.x, lane = tid & 63, wave = __builtin_amdgcn_readfirstlane(tid >> 6);
#define FRESH_IDS() do { tid = threadIdx.x; asm volatile("" : "+v"(tid)); lane = tid & 63; wave = __builtin_amdgcn_readfirstlane(tid >> 6); } while (0)

    if (blockIdx.x == 0 && tid < 3) __hip_atomic_store(ctl + 64 * tid, 0u, __ATOMIC_RELAXED, __HIP_MEMORY_SCOPE_AGENT);
    p0_prologue(p, lds, tid, wave, lane);
    grid.sync();
    FRESH_IDS();
    {
        pg8::Gemm g{(const bf16_t*)(p.ws + WS_XB), (const bf16_t*)(p.ws + WS_WIN), NTOK, NIN, DM};
        pg8::StaticOrder S; S.init(NTOK, NIN, (int)gridDim.x, (int)blockIdx.x);
        EpiIn E{(bf16_t*)(p.ws + WS_HYT), (bf16_t*)(p.ws + WS_PROJ)};
        pg8::gemm_phase2<EpiIn, pg8::StaticOrder, GEMM_ALIGN, GEMM_SP2>(lds, g, S, E);
    }
    grid_bar(ctl + 0, gridDim.x);
    FRESH_IDS();
    {
        const int vcu = ((gridDim.x & 7) == 0) ? (int)((blockIdx.x & 7) * (gridDim.x >> 3) + (blockIdx.x >> 3)) : (int)blockIdx.x;
        for (int u = vcu; u < NB * 16; u += gridDim.x) attn_unit(p, lds, u, tid, wave, lane);
    }
    FRESH_IDS();
    {
        const int vcu = ((gridDim.x & 7) == 0) ? (int)((blockIdx.x & 7) * (gridDim.x >> 3) + (blockIdx.x >> 3)) : (int)blockIdx.x;
        for (int u = vcu; u < DH; u += gridDim.x) hyena_unit(p, lds, u, tid, wave, lane);
    }
    grid_bar(ctl + 64, gridDim.x);
    FRESH_IDS();
    {
        LAS float* scr = (LAS float*)(lds + wave * 16384);
        bf16_t* WoutT = (bf16_t*)(p.ws + WS_WOUT);
#pragma unroll 1
        for (int it = blockIdx.x * 8 + wave; it < (DM / 64) * (DM / 32); it += gridDim.x * 8) {
            const int kb = it / (DM / 32);
            p0_transpose_item(p.in[19], (kb < 8) ? p.in[17] : (p.in[18] - 512), DM, DM, WoutT, scr, it, lane);
        }
        __syncthreads();
    }
    for (int u = blockIdx.x; u < NTOK / 64; u += gridDim.x) p3_unit(p, lds, u, tid, wave, lane);
    grid_bar(ctl + 128, gridDim.x);
    FRESH_IDS();
    {
        pg8::Gemm g{(const bf16_t*)(p.ws + WS_Y), (const bf16_t*)(p.ws + WS_WOUT), NTOK, DM, DM};
        pg8::StaticOrder S; S.init(NTOK, DM, (int)gridDim.x, (int)blockIdx.x);
        EpiOut E{p.in[0], p.out};
        pg8::gemm_phase2<EpiOut, pg8::StaticOrder, GEMM_ALIGN, GEMM_SP2>(lds, g, S, E);
    }
}

extern "C" void kernel_launch(void* const* d_in, const int* in_sizes, int n_in, void* d_out, int out_size, void* d_ws, size_t ws_size, hipStream_t stream) {
    static int grid = 0;
    if (grid == 0) {
        if (n_in != 20 || ws_size < WS_END) { fprintf(stderr, "kernel_launch: unexpected inputs (n_in %d, ws %zu < %zu)\n", n_in, ws_size, (size_t)WS_END); grid = -1; return; }
        int dev = 0, cus = 0, per_cu = 0;
        hipGetDevice(&dev);
        hipDeviceGetAttribute(&cus, hipDeviceAttributeMultiprocessorCount, dev);
        if (hipFuncSetAttribute((const void*)hymba_fwd, hipFuncAttributeMaxDynamicSharedMemorySize, LDS_BYTES) != hipSuccess) fprintf(stderr, "kernel_launch: hipFuncSetAttribute failed\n");
        if (hipOccupancyMaxActiveBlocksPerMultiprocessor(&per_cu, (const void*)hymba_fwd, NTHREADS, LDS_BYTES) != hipSuccess || per_cu < 1) { fprintf(stderr, "kernel_launch: occupancy query gave %d\n", per_cu); per_cu = 1; }
        (void)hipGetLastError();
        grid = cus * (per_cu > 1 ? 1 : per_cu);
        if (grid > 256) grid = 256;
    }
    if (grid < 0) return;
    Params p{};
    for (int i = 0; i < 20; ++i) p.in[i] = (const float*)d_in[i];
    p.out = (float*)d_out; p.ws = (unsigned char*)d_ws;
    void* args[] = {&p};
    hipError_t e = hipLaunchCooperativeKernel((const void*)hymba_fwd, dim3(grid), dim3(NTHREADS), args, LDS_BYTES, stream);
    if (e != hipSuccess) fprintf(stderr, "cooperative launch failed: %s (grid %d)\n", hipGetErrorString(e), grid);
}
```

```cpp
#include <hip/hip_runtime.h>
#include <hip/hip_cooperative_groups.h>
#include <cstdio>
namespace cg = cooperative_groups;
namespace pg8 {
#define PG8_LAS __attribute__((address_space(3)))
typedef unsigned short bf16_t;
typedef short bf16x8 __attribute__((ext_vector_type(8)));
typedef float f32x4 __attribute__((ext_vector_type(4)));
typedef unsigned u32x4 __attribute__((ext_vector_type(4)));
constexpr int BM = 256, BK = 64, HALF = 128, HTB = HALF * BK * 2  , STAGE_BYTES = 8 * HTB, NXCD = 8, WGM = 4;

__host__ __device__ __forceinline__ int lds_byte(int r, int c) { const int st = (r >> 4) * 2 + (c >> 5), rr = r & 15, cc = c & 31, ob = rr * 64 + cc * 2; return st * 1024 + (ob ^ (((ob >> 9) & 1) << 5)); }
__host__ __device__ __forceinline__ void stage_rc(int b, int& R, int& C) { const int st = b / 1024, sb = b % 1024, swz = sb ^ (((sb >> 9) & 1) << 5); R = (st >> 1) * 16 + swz / 64; C = (st & 1) * 32 + (swz % 64) / 2; }
__host__ __device__ __forceinline__ int perm32(int rho) { const int n = rho >> 4, i = rho & 15; return 8 * (i >> 2) + 4 * n + (i & 3); }

struct Unit { int pm, pn; };
struct Gemm { const bf16_t* A; const bf16_t* Bt; int M, N, K; };

struct StaticOrder {
    int nM, nN, nwg, G, c;
    __host__ __device__ void init(int M, int N, int G_, int c_) { nM = M / BM; nN = N / BM; nwg = nM * nN; G = G_; c = c_; }
    __host__ __device__ bool next(int i, Unit& u) const {
        const long L = (long)i * G + c; if (L >= nwg) return false;
        int wgid = (int)L; { const int q = nwg / NXCD, r = nwg % NXCD, xcd = wgid % NXCD, off = wgid / NXCD; wgid = (xcd < r ? xcd * (q + 1) : r * (q + 1) + (xcd - r) * q) + off; }
        const int nig = WGM * nN, gid = wgid / nig, fm = gid * WGM, gsz = (nM - fm) < WGM ? (nM - fm) : WGM;
        u.pm = fm + ((wgid % nig) % gsz); u.pn = (wgid % nig) / gsz; return true;
    }
    __device__ __forceinline__ void a_ready(const Unit&) const {}
    __device__ __forceinline__ void done(const Unit&) const {}
};

template <class Epi, class Sched, bool ALIGN_EPI = false, bool SP2 = false>
__device__ __forceinline__ void gemm_phase2(PG8_LAS unsigned char* lds, const Gemm g, const Sched& S, const Epi& E) {
    int tid_raw = threadIdx.x; asm volatile("" : "+v"(tid_raw));
    const int tid = tid_raw, wid = __builtin_amdgcn_readfirstlane(tid >> 6), lane = tid & 63, wr = wid >> 2, wc = wid & 3, fr = lane & 15, fq = lane >> 4;
    const int K = g.K, nt = K / BK;
    unsigned voffA[2], voffB[2];
#pragma unroll
    for (int i = 0; i < 2; ++i) { int R, C; stage_rc(tid * 16 + i * 8192, R, C); const int Rb = Epi::PERM ? ((R & ~31) + perm32(R & 31)) : R;
        const int Ra = Epi::APERM ? (128 * (R >> 6) + 8 * (R & 15) + ((R >> 4) & 3)) : R; voffA[i] = (unsigned)(Ra * K + C) * 2u; voffB[i] = (unsigned)(Rb * K + C) * 2u; }
    const size_t kstep = (size_t)(BK * 2);
    const size_t hstep = (size_t)HALF * K * 2;
    const size_t tstep = 2 * hstep;
    const size_t hstepA = Epi::APERM ? (size_t)4 * K * 2 : hstep;
    const unsigned ldsw = (unsigned)wid * 1024u;
    const int aoff = lds_byte(wr * 64 + fr, fq * 8), boff = lds_byte(wc * 32 + fr, fq * 8);
#define PG8_SA(b, h) (((b) * 2 + (h)) * HTB)
#define PG8_SB(b, h) ((4 + (b) * 2 + (h)) * HTB)
#define PG8_STAGE(bufoff, gbase, voff) do { _Pragma("unroll") for (int _i = 0; _i < 2; ++_i) \
        __builtin_amdgcn_global_load_lds((const unsigned*)((const char*)(gbase) + (voff)[_i]), (PG8_LAS unsigned*)(lds + (bufoff) + ldsw + _i * 8192), 16, 0, 0); } while (0)
#define PG8_LDA(dst, b, h) do { _Pragma("unroll") for (int m = 0; m < 4; ++m) _Pragma("unroll") for (int k = 0; k < 2; ++k) dst[m][k] = *(const PG8_LAS bf16x8*)(lds + PG8_SA(b, h) + aoff + m * 2048 + k * 1024); } while (0)
#define PG8_LDB(dst, b, h) do { _Pragma("unroll") for (int n = 0; n < 2; ++n) _Pragma("unroll") for (int k = 0; k < 2; ++k) dst[n][k] = *(const PG8_LAS bf16x8*)(lds + PG8_SB(b, h) + boff + n * 2048 + k * 1024); } while (0)
#define PG8_MMA(ai, bj, At, Bt) do { __builtin_amdgcn_s_setprio(1); _Pragma("unroll") for (int m = 0; m < 4; ++m) _Pragma("unroll") for (int n = 0; n < 2; ++n) _Pragma("unroll") for (int k = 0; k < 2; ++k) \
        acc[ai][bj][m][n] = __builtin_amdgcn_mfma_f32_16x16x32_bf16(Bt[n][k], At[m][k], acc[ai][bj][m][n], 0, 0, 0); __builtin_amdgcn_s_setprio(0); } while (0)
#define PG8_WAIT_V(n) asm volatile("s_waitcnt vmcnt(" #n ")" ::: "memory")
#define PG8_WAIT_L(n) asm volatile("s_waitcnt lgkmcnt(" #n ")" ::: "memory")
#define PG8_BAR __builtin_amdgcn_s_barrier()
#define PG8_SCHED __builtin_amdgcn_sched_barrier(0)
    Unit cur, nxt; int ui = 0;
    if (!S.next(0, cur)) return;
    f32x4 acc[2][2][4][2];
#pragma unroll
    for (int a = 0; a < 2; ++a)
#pragma unroll
        for (int b = 0; b < 2; ++b)
#pragma unroll
            for (int m = 0; m < 4; ++m)
#pragma unroll
                for (int n = 0; n < 2; ++n) acc[a][b][m][n] = (f32x4){0.f, 0.f, 0.f, 0.f};
    bf16x8 At[4][2], B0[2][2], B1[2][2];
    const char* cA = (const char*)g.A + (size_t)cur.pm * tstep; const char* cB = (const char*)g.Bt + (size_t)cur.pn * tstep;
    S.a_ready(cur);
    if constexpr (SP2) {
        PG8_STAGE(PG8_SB(0, 0), cB, voffB); PG8_STAGE(PG8_SB(0, 1), cB + hstep, voffB); PG8_STAGE(PG8_SA(0, 0), cA, voffA); PG8_STAGE(PG8_SA(0, 1), cA + hstepA, voffA);
        if (wr == 1) PG8_BAR;
        PG8_WAIT_V(2); PG8_BAR;
        PG8_STAGE(PG8_SB(1, 0), cB + kstep, voffB); PG8_STAGE(PG8_SA(1, 0), cA + kstep, voffA); PG8_STAGE(PG8_SB(1, 1), cB + hstep + kstep, voffB);
        PG8_WAIT_V(6); PG8_BAR;
    } else {
        PG8_STAGE(PG8_SB(0, 0), cB, voffB); PG8_STAGE(PG8_SA(0, 0), cA, voffA); PG8_STAGE(PG8_SB(0, 1), cB + hstep, voffB); PG8_STAGE(PG8_SA(0, 1), cA + hstepA, voffA);
        if (wr == 1) PG8_BAR;
        PG8_WAIT_V(4); PG8_BAR;
        PG8_STAGE(PG8_SB(1, 0), cB + kstep, voffB); PG8_STAGE(PG8_SA(1, 0), cA + kstep, voffA); PG8_STAGE(PG8_SB(1, 1), cB + hstep + kstep, voffB);
        PG8_WAIT_V(6); PG8_BAR;
    }
    for (;;) {
        const bool has_next = S.next(ui + 1, nxt);
        const char* nA = has_next ? (const char*)g.A + (size_t)nxt.pm * tstep : cA; const char* nB = has_next ? (const char*)g.Bt + (size_t)nxt.pn * tstep : cB;
        for (int t = 0; t < nt; t += 2) {
            const bool last = (t == nt - 2);
            const char* a1 = cA + (size_t)(t + 1) * kstep;
            const char* a2 = last ? nA : cA + (size_t)(t + 2) * kstep; const char* b2 = last ? nB : cB + (size_t)(t + 2) * kstep;
            const char* a3 = a2 + kstep; const char* b3 = b2 + kstep;
            if (last && has_next) S.a_ready(nxt);
            if constexpr (SP2) {
            PG8_LDB(B0, 0, 0); PG8_LDB(B1, 0, 1); PG8_SCHED; PG8_LDA(At, 0, 0); PG8_STAGE(PG8_SA(1, 1), a1 + hstepA, voffA);
            PG8_WAIT_V(8); PG8_WAIT_L(0); PG8_BAR; PG8_MMA(0, 0, At, B0); PG8_MMA(0, 1, At, B1); PG8_BAR; PG8_SCHED;
            PG8_LDA(At, 0, 1); PG8_STAGE(PG8_SB(0, 0), b2, voffB); PG8_STAGE(PG8_SB(0, 1), b2 + hstep, voffB); PG8_STAGE(PG8_SA(0, 0), a2, voffA);
            PG8_WAIT_V(8); PG8_WAIT_L(0); PG8_BAR; PG8_MMA(1, 0, At, B0); PG8_MMA(1, 1, At, B1); PG8_BAR; PG8_SCHED;
            PG8_LDB(B0, 1, 0); PG8_LDB(B1, 1, 1); PG8_SCHED; PG8_LDA(At, 1, 0); PG8_STAGE(PG8_SA(0, 1), a2 + hstepA, voffA);
            PG8_WAIT_V(8); PG8_WAIT_L(0); PG8_BAR; PG8_MMA(0, 0, At, B0); PG8_MMA(0, 1, At, B1); PG8_BAR; PG8_SCHED;
            PG8_LDA(At, 1, 1); PG8_STAGE(PG8_SB(1, 0), b3, voffB); PG8_STAGE(PG8_SB(1, 1), b3 + hstep, voffB); PG8_STAGE(PG8_SA(1, 0), a3, voffA);
            PG8_WAIT_V(8); PG8_WAIT_L(0); PG8_BAR; PG8_MMA(1, 0, At, B0); PG8_MMA(1, 1, At, B1); PG8_BAR; PG8_SCHED;
            } else {
            PG8_LDB(B0, 0, 0); PG8_SCHED; PG8_LDA(At, 0, 0); PG8_STAGE(PG8_SA(1, 1), a1 + hstepA, voffA);
            PG8_WAIT_L(8); PG8_BAR; PG8_WAIT_L(0); PG8_MMA(0, 0, At, B0); PG8_BAR; PG8_SCHED;
            PG8_LDB(B1, 0, 1); PG8_STAGE(PG8_SB(0, 0), b2, voffB);
            PG8_BAR; PG8_WAIT_L(0); PG8_MMA(0, 1, At, B1); PG8_BAR;
            PG8_LDA(At, 0, 1); PG8_STAGE(PG8_SA(0, 0), a2, voffA);
            PG8_BAR; PG8_WAIT_L(0); PG8_MMA(1, 0, At, B0); PG8_BAR; PG8_SCHED;
            PG8_STAGE(PG8_SB(0, 1), b2 + hstep, voffB);
            PG8_WAIT_V(6); PG8_BAR; PG8_MMA(1, 1, At, B1); PG8_BAR;
            PG8_LDB(B0, 1, 0); PG8_SCHED; PG8_LDA(At, 1, 0); PG8_STAGE(PG8_SA(0, 1), a2 + hstepA, voffA);
            PG8_WAIT_L(8); PG8_BAR; PG8_WAIT_L(0); PG8_MMA(0, 0, At, B0); PG8_BAR; PG8_SCHED;
            PG8_LDB(B1, 1, 1); PG8_STAGE(PG8_SB(1, 0), b3, voffB);
            PG8_BAR; PG8_WAIT_L(0); PG8_MMA(0, 1, At, B1); PG8_BAR;
            PG8_LDA(At, 1, 1); PG8_STAGE(PG8_SA(1, 0), a3, voffA);
            PG8_BAR; PG8_WAIT_L(0); PG8_MMA(1, 0, At, B0); PG8_BAR; PG8_SCHED;
            PG8_STAGE(PG8_SB(1, 1), b3 + hstep, voffB);
            PG8_WAIT_V(6); PG8_BAR; PG8_MMA(1, 1, At, B1); PG8_BAR;
            }
        }
        if constexpr (ALIGN_EPI) { if (wr == 0) PG8_BAR; }
        if constexpr (!Epi::AFTER_DRAIN) { E(acc, cur, wr, wc, fr, fq); S.done(cur); }
        if (!has_next) break;
#pragma unroll
        for (int a = 0; a < 2; ++a)
#pragma unroll
            for (int b = 0; b < 2; ++b)
#pragma unroll
                for (int m = 0; m < 4; ++m)
#pragma unroll
                    for (int n = 0; n < 2; ++n) acc[a][b][m][n] = (f32x4){0.f, 0.f, 0.f, 0.f};
        cur = nxt; cA = nA; cB = nB; ++ui;
        if constexpr (ALIGN_EPI) { if (wr == 1) PG8_BAR; }
    }
    PG8_WAIT_V(0);
    if constexpr (!ALIGN_EPI) { if (wr == 0) PG8_BAR; }
    PG8_BAR;
    if constexpr (Epi::AFTER_DRAIN) { E.fused(acc, cur, wr, wc, fr, fq, lds, wid, lane); S.done(cur); }
#undef PG8_SA
#undef PG8_SB
#undef PG8_STAGE
#undef PG8_LDA
#undef PG8_LDB
#undef PG8_MMA
#undef PG8_WAIT_V
#undef PG8_WAIT_L
#undef PG8_BAR
#undef PG8_SCHED
}
}

#define LAS __attribute__((address_space(3)))
using pg8::bf16_t; using pg8::bf16x8; using pg8::f32x4; using pg8::u32x4;
typedef float f32x16 __attribute__((ext_vector_type(16)));
typedef unsigned u32x2 __attribute__((ext_vector_type(2)));
typedef __bf16 bf2_t __attribute__((ext_vector_type(2)));
typedef float f32x2 __attribute__((ext_vector_type(2)));

constexpr int NB = 32, SEQ = 2048, DM = 1024, NTOK = NB * SEQ, NIN = 3328, DH = 512, NPROJ = 1792;
constexpr int PJ_GH = 0, PJ_Q = 512, PJ_K = 1024, PJ_V = 1152, PJ_GA = 1280;
constexpr float EPS = 1e-6f;
constexpr size_t WS_WIN = 0;
constexpr size_t WS_WOUT = WS_WIN + (size_t)NIN * DM * 2;
constexpr size_t WS_RF = WS_WOUT + (size_t)DM * DM * 2;
constexpr size_t WS_ROPE = WS_RF + (size_t)2 * DH * 4096 * 2;
constexpr size_t WS_XB = WS_ROPE + (size_t)SEQ * 32 * 4 * 2;
constexpr size_t WS_HYT = WS_XB + (size_t)NTOK * DM * 2;
constexpr size_t WS_PROJ = WS_HYT + (size_t)1536 * NTOK * 2;
constexpr size_t WS_ZT = WS_PROJ + (size_t)NTOK * NPROJ * 2;
constexpr size_t WS_YA = WS_ZT + (size_t)DH * NTOK * 2;
constexpr size_t WS_Y = WS_YA + (size_t)NTOK * DH * 2;
constexpr size_t WS_CTL = WS_Y + (size_t)NTOK * DM * 2;
constexpr size_t WS_END = WS_CTL + 4096;
constexpr int LDS_BYTES = 144 * 1024;
constexpr int NTHREADS = 512;
#ifndef GEMM_ALIGN
#define GEMM_ALIGN true
#endif
#ifndef GEMM_SP2
#define GEMM_SP2 true
#endif

#define LDS_WAIT() asm volatile("s_waitcnt lgkmcnt(0)" ::: "memory")
#define MFMA32(a, b, c) __builtin_amdgcn_mfma_f32_32x32x16_bf16((a), (b), (c), 0, 0, 0)

__device__ __forceinline__ unsigned pk2(float lo, float hi) { f32x2 v = {lo, hi}; bf2_t b = __builtin_convertvector(v, bf2_t); return __builtin_bit_cast(unsigned, b); }
__device__ __forceinline__ float bf_lo(unsigned w) { return __uint_as_float(w << 16); }
__device__ __forceinline__ float bf_hi(unsigned w) { return __uint_as_float(w & 0xffff0000u); }
__device__ __forceinline__ float bf1(bf16_t v) { return __uint_as_float(((unsigned)v) << 16); }
__device__ __forceinline__ float wave_sum(float v) {
#pragma unroll
    for (int o = 1; o < 64; o <<= 1) v += __shfl_xor(v, o);
    return v;
}

__device__ __forceinline__ float sin_acc(float x) { double r = (double)x * 0.15915494309189535; r -= rint(r); return __builtin_amdgcn_sinf((float)r); }
__device__ __forceinline__ float cos_acc(float x) { double r = (double)x * 0.15915494309189535; r -= rint(r); return __builtin_amdgcn_cosf((float)r); }
__device__ __forceinline__ float silu_f(float v) { return v * __builtin_amdgcn_rcpf(1.0f + __expf(-v)); }

struct EpiIn {
    static constexpr bool PERM = true, APERM = true, AFTER_DRAIN = false;
    bf16_t* hyt; bf16_t* proj;
    __device__ __forceinline__ void prefetch(const pg8::Unit&, int, float (&)[4]) const {}
    __device__ __forceinline__ void prefetch_done(float (&)[4]) const {}
    __device__ __forceinline__ void operator()(const f32x4 (&acc)[2][2][4][2], const pg8::Unit& u, int wr, int wc, int fr, int fq) const {
        const int tok0 = u.pm * 256 + wr * 128 + 8 * fr;
        if (u.pn < 6) {
            const int col0 = u.pn * 256 + wc * 32 + 8 * fq;
#pragma unroll
            for (int bj = 0; bj < 2; ++bj)
#pragma unroll
                for (int n = 0; n < 2; ++n)
#pragma unroll
                    for (int j = 0; j < 4; ++j) {
                        const int col = col0 + bj * 128 + 4 * n + j;
                        u32x4 w;
                        w.x = pk2(acc[0][bj][0][n][j], acc[0][bj][1][n][j]); w.y = pk2(acc[0][bj][2][n][j], acc[0][bj][3][n][j]);
                        w.z = pk2(acc[1][bj][0][n][j], acc[1][bj][1][n][j]); w.w = pk2(acc[1][bj][2][n][j], acc[1][bj][3][n][j]);
                        *(u32x4*)(hyt + (size_t)col * NTOK + tok0) = w;
                    }
        } else {
            const int pc0 = u.pn * 256 - 1536 + wc * 32 + 8 * fq;
#pragma unroll
            for (int ai = 0; ai < 2; ++ai)
#pragma unroll
                for (int m = 0; m < 4; ++m) {
                    bf16_t* rowp = proj + (size_t)(tok0 + 4 * ai + m) * NPROJ + pc0;
#pragma unroll
                    for (int bj = 0; bj < 2; ++bj) {
                        const f32x4 v0 = acc[ai][bj][m][0], v1 = acc[ai][bj][m][1];
                        u32x4 w; w.x = pk2(v0[0], v0[1]); w.y = pk2(v0[2], v0[3]); w.z = pk2(v1[0], v1[1]); w.w = pk2(v1[2], v1[3]);
                        *(u32x4*)(rowp + bj * 128) = w;
                    }
                }
        }
    }
};
struct EpiOut {
    static constexpr bool PERM = false, APERM = false, AFTER_DRAIN = false;
    const float* x; float* out;
    __device__ __forceinline__ void prefetch(const pg8::Unit& u, int tid, float (&pf)[4]) const {
#pragma unroll
        for (int i = 0; i < 4; ++i) { const int line = tid + 512 * i, r = line >> 3, c = (line & 7) * 32; pf[i] = x[(size_t)(u.pm * 256 + r) * DM + u.pn * 256 + c]; }
    }
    __device__ __forceinline__ void prefetch_done(float (&pf)[4]) const { asm volatile("" :: "v"(pf[0]), "v"(pf[1]), "v"(pf[2]), "v"(pf[3])); }
    __device__ __forceinline__ void operator()(const f32x4 (&acc)[2][2][4][2], const pg8::Unit& u, int wr, int wc, int fr, int fq) const {
        const int row0 = u.pm * 256 + wr * 64 + fr, col0 = u.pn * 256 + wc * 32 + 4 * fq;
        const float* xb = x + (size_t)row0 * DM + col0; float* ob = out + (size_t)row0 * DM + col0;
#pragma unroll
        for (int ai = 0; ai < 2; ++ai)
#pragma unroll
            for (int mp = 0; mp < 2; ++mp) {
                f32x4 xv[2][2][2];
#pragma unroll
                for (int mm = 0; mm < 2; ++mm)
#pragma unroll
                    for (int bj = 0; bj < 2; ++bj)
#pragma unroll
                        for (int n = 0; n < 2; ++n) xv[mm][bj][n] = *(const f32x4*)(xb + (size_t)(ai * 128 + (2 * mp + mm) * 16) * DM + bj * 128 + n * 16);
                __builtin_amdgcn_sched_barrier(0);
#pragma unroll
                for (int mm = 0; mm < 2; ++mm)
#pragma unroll
                    for (int bj = 0; bj < 2; ++bj)
#pragma unroll
                        for (int n = 0; n < 2; ++n) *(f32x4*)(ob + (size_t)(ai * 128 + (2 * mp + mm) * 16) * DM + bj * 128 + n * 16) = xv[mm][bj][n] + acc[ai][bj][2 * mp + mm][n];
                __builtin_amdgcn_sched_barrier(0);
            }
    }
};

__device__ __forceinline__ void p0_transpose_item(const float* W, const float* gk, int K, int N, bf16_t* WT, LAS float* scr, int item, int lane) {
    const int nblk = N / 32, kb = item / nblk, nb = item % nblk, k0 = 64 * kb, n0 = 32 * nb;
#pragma unroll 8
    for (int i = 0; i < 32; ++i) { const int kk = 2 * i + (lane >> 5); scr[kk * 33 + (lane & 31)] = W[(size_t)(k0 + kk) * N + n0 + (lane & 31)] * gk[k0 + kk]; }
    LDS_WAIT();
    const int c = lane & 7;
#pragma unroll
    for (int j = 0; j < 4; ++j) {
        const int n = (lane >> 3) + 8 * j; const LAS float* s = scr + (8 * c) * 33 + n;
        u32x4 o; o.x = pk2(s[0 * 33], s[1 * 33]); o.y = pk2(s[2 * 33], s[3 * 33]); o.z = pk2(s[4 * 33], s[5 * 33]); o.w = pk2(s[6 * 33], s[7 * 33]);
        *(u32x4*)(WT + (size_t)(n0 + n) * K + k0 + 8 * c) = o;
    }
    LDS_WAIT();
}

struct Params { const float* in[20]; float* out; unsigned char* ws; };

__device__ __forceinline__ void p0_prologue(const Params& p, LAS unsigned char* lds, int tid, int wave, int lane) {
    LAS float* scr = (LAS float*)(lds + wave * 16384);
    const int gw = blockIdx.x * 8 + wave, NGW = gridDim.x * 8;
    bf16_t* WinT = (bf16_t*)(p.ws + WS_WIN); bf16_t* WoutT = (bf16_t*)(p.ws + WS_WOUT); bf16_t* RF = (bf16_t*)(p.ws + WS_RF);
    float* ROPE = (float*)(p.ws + WS_ROPE); bf16_t* XB = (bf16_t*)(p.ws + WS_XB);
    constexpr int I_IN = (DM / 64) * (NIN / 32);
#pragma unroll 1
    for (int it = gw; it < I_IN; it += NGW) p0_transpose_item(p.in[2], p.in[1], DM, NIN, WinT, scr, it, lane);
    __syncthreads();
    {
        const float* w1 = p.in[5]; const float* b1 = p.in[6]; const float* w2 = p.in[7]; const float* b2 = p.in[8];
        const float* w3 = p.in[9]; const float* b3 = p.in[10]; const float* w4 = p.in[11]; const float* sf = p.in[12];
        const float* hbias = p.in[13];
#pragma unroll 1
        for (int l = gw; l < SEQ; l += NGW) {
            const float t = (float)l / 2047.0f;
            const float w = 6.283185307179586f * (float)l / 2048.0f;
            if (lane < 33) {
                float zi;
                if (lane == 0) zi = t;
                else { const int i = (lane - 1) & 15; const float f = 1e-4f + (float)i * ((15.0f - 1e-4f) / 15.0f); const float a = f * w; zi = (lane <= 16) ? cos_acc(a) : -sin_acc(a); }
                scr[lane] = zi;
            }
            LDS_WAIT();
            const float fr = sf[lane];
            float a = b1[lane];
#pragma unroll 11
            for (int i = 0; i < 33; ++i) a += scr[i] * w1[i * 64 + lane];
            scr[64 + lane] = sin_acc(fr * a);
            LDS_WAIT();
            a = b2[lane];
#pragma unroll 16
            for (int i = 0; i < 64; ++i) a += scr[64 + i] * w2[i * 64 + lane];
            scr[128 + lane] = sin_acc(fr * a);
            LDS_WAIT();
            a = b3[lane];
#pragma unroll 16
            for (int i = 0; i < 64; ++i) a += scr[128 + i] * w3[i * 64 + lane];
            scr[192 + lane] = sin_acc(fr * a);
            LDS_WAIT();
            {
                f32x4 acc4[8];
#pragma unroll
                for (int i = 0; i < 8; ++i) acc4[i] = (f32x4){0.f, 0.f, 0.f, 0.f};
                const f32x4* w4v = (const f32x4*)w4;
                f32x4 stg[8];
#pragma unroll
                for (int q = 0; q < 8; ++q) stg[q] = w4v[tid + 512 * q];
#pragma unroll 1
                for (int jc = 0; jc < 64; jc += 8) {
                    __syncthreads();
#pragma unroll
                    for (int q = 0; q < 8; ++q) { const int idx = tid + 512 * q; *(LAS f32x4*)(lds + (idx >> 9) * 16384 + 8192 + (idx & 511) * 16) = stg[q]; }
                    if (jc + 8 < 64) {
#pragma unroll
                        for (int q = 0; q < 8; ++q) stg[q] = w4v[(jc + 8) * 512 + tid + 512 * q];
                    }
                    __syncthreads();
#pragma unroll
                    for (int jj = 0; jj < 8; ++jj) {
                        const float hj = scr[192 + jc + jj];
                        const LAS f32x4* wr4 = (const LAS f32x4*)(lds + jj * 16384 + 8192) + lane;
#pragma unroll
                        for (int i = 0; i < 8; ++i) acc4[i] += hj * wr4[64 * i];
                    }
                }
#pragma unroll
                for (int i = 0; i < 8; ++i) {
                    float val[4];
#pragma unroll
                    for (int e = 0; e < 4; ++e) {
                        const int n = 4 * lane + 256 * i + e;
                        const int o = n >> 10, dir = (n >> 9) & 1, c = n & 511;
                        const float ad = 3.0701134573f + (float)c * ((15.3505672866f - 3.0701134573f) / 511.0f);
                        val[e] = acc4[i][e] * __expf(-t * ad);
                        if (l == 0 && dir == 0) val[e] += hbias[o * 512 + c];
                    }
                    u32x2 w; w.x = pk2(val[0], val[1]); w.y = pk2(val[2], val[3]);
                    *(u32x2*)(RF + (size_t)l * 2048 + 4 * lane + 256 * i) = w;
                }
            }
            LDS_WAIT();
        }
    }
    for (int idx = blockIdx.x * NTHREADS + tid; idx < SEQ * 32; idx += gridDim.x * NTHREADS) {
        const int pos = idx >> 5, i = idx & 31;
        const float inv = exp2f(-(float)i * (13.287712379549449f / 32.0f));
        const float ang = (float)pos * inv;
        ROPE[idx] = cos_acc(ang); ROPE[SEQ * 32 + idx] = sin_acc(ang);
    }
    {
        const float* x = p.in[0];
#pragma unroll 1
        for (int m = gw; m < NTOK; m += 2 * NGW) {
            const int m2 = m + NGW;
            const bool has2 = m2 < NTOK;
            const f32x4* xr = (const f32x4*)(x + (size_t)m * DM) + lane;
            const f32x4* xr2 = (const f32x4*)(x + (size_t)(has2 ? m2 : m) * DM) + lane;
            f32x4 v[4], v2[4]; float s = 0.f, s2 = 0.f;
#pragma unroll
            for (int j = 0; j < 4; ++j) { v[j] = __builtin_nontemporal_load(xr + 64 * j); v2[j] = __builtin_nontemporal_load(xr2 + 64 * j); }
#pragma unroll
            for (int j = 0; j < 4; ++j) { s += (v[j].x * v[j].x + v[j].y * v[j].y) + (v[j].z * v[j].z + v[j].w * v[j].w); s2 += (v2[j].x * v2[j].x + v2[j].y * v2[j].y) + (v2[j].z * v2[j].z + v2[j].w * v2[j].w); }
            const float rstd = 1.0f / sqrtf(wave_sum(s) * (1.0f / DM) + EPS), rstd2 = 1.0f / sqrtf(wave_sum(s2) * (1.0f / DM) + EPS);
            u32x2* o8 = (u32x2*)(XB + (size_t)m * DM) + lane;
#pragma unroll
            for (int j = 0; j < 4; ++j) { u32x2 w; w.x = pk2(v[j].x * rstd, v[j].y * rstd); w.y = pk2(v[j].z * rstd, v[j].w * rstd); o8[64 * j] = w; }
            if (has2) {
                u32x2* o82 = (u32x2*)(XB + (size_t)m2 * DM) + lane;
#pragma unroll
                for (int j = 0; j < 4; ++j) { u32x2 w; w.x = pk2(v2[j].x * rstd2, v2[j].y * rstd2); w.y = pk2(v2[j].z * rstd2, v2[j].w * rstd2); o82[64 * j] = w; }
            }
        }
    }
}

constexpr int UROWB = 4112;
constexpr int HY_R_OFF = 32 * UROWB;

__device__ __forceinline__ bf16x8 load_afrag(const LAS unsigned* Rw, int n0) {
    const int dw = n0 >> 1; const unsigned sh = (unsigned)(n0 & 1) << 4;
    const unsigned d0 = Rw[dw], d1 = Rw[dw + 1], d2 = Rw[dw + 2], d3 = Rw[dw + 3], d4 = Rw[dw + 4];
    u32x4 f;
    f.x = __builtin_amdgcn_alignbit(d1, d0, sh); f.y = __builtin_amdgcn_alignbit(d2, d1, sh);
    f.z = __builtin_amdgcn_alignbit(d3, d2, sh); f.w = __builtin_amdgcn_alignbit(d4, d3, sh);
    return __builtin_bit_cast(bf16x8, f);
}
__device__ __forceinline__ void hy_conv(f32x16 (&acc)[8], const LAS unsigned char* lds, int wave, int i32, int h) {
    const LAS unsigned* Rw = (const LAS unsigned*)(lds + HY_R_OFF);
    const LAS unsigned char* Ub = lds + i32 * UROWB + 16 * h;
    const int nbase = 2048 - 256 * wave - i32 + 8 * h;
    bf16x8 AE[8], AO[8];
#pragma unroll
    for (int r = 0; r < 8; ++r) {
#pragma unroll
        for (int i = 0; i < 16; ++i) acc[r][i] = 0.f;
        AE[r] = load_afrag(Rw, nbase - 32 * r); AO[r] = load_afrag(Rw, nbase - 32 * r + 16);
    }
    for (int P = 0; P < 8; ++P) {
#pragma unroll
        for (int p = 0; p < 8; ++p) {
            const int S = 8 * P + p;
            const bf16x8 Be = *(const LAS bf16x8*)(Ub + 64 * S), Bo = *(const LAS bf16x8*)(Ub + 64 * S + 32);
#pragma unroll
            for (int r = 0; r < 8; ++r) {
                acc[r] = MFMA32(AE[(r - p) & 7], Be, acc[r]);
                acc[r] = MFMA32(AO[(r - p) & 7], Bo, acc[r]);
            }
            if (S + 1 < 64) { AE[(7 - p) & 7] = load_afrag(Rw, nbase + 32 * (S + 1)); AO[(7 - p) & 7] = load_afrag(Rw, nbase + 32 * (S + 1) + 16); }
        }
    }
}

__device__ __forceinline__ void hy_stage(LAS unsigned char* lds, const bf16_t* hy, float w0, float w1, float w2, float bias, int tid) {
#pragma unroll 4
    for (int ch = tid; ch < 8192; ch += NTHREADS) {
        const int b = ch >> 8, t0 = (ch & 255) << 3; const bf16_t* row = hy + b * SEQ;
        const u32x4 v = *(const u32x4*)(row + t0);
        float x[10];
        x[0] = bf1(row[(t0 > 0) ? t0 - 1 : 0]); x[9] = bf1(row[(t0 + 8 < SEQ) ? t0 + 8 : SEQ - 1]);
        x[0] = (t0 > 0) ? x[0] : 0.f; x[9] = (t0 + 8 < SEQ) ? x[9] : 0.f;
        x[1] = bf_lo(v.x); x[2] = bf_hi(v.x); x[3] = bf_lo(v.y); x[4] = bf_hi(v.y); x[5] = bf_lo(v.z); x[6] = bf_hi(v.z); x[7] = bf_lo(v.w); x[8] = bf_hi(v.w);
        float o[8];
#pragma unroll
        for (int j = 0; j < 8; ++j) o[j] = bias + w0 * x[j] + w1 * x[j + 1] + w2 * x[j + 2];
        u32x4 w; w.x = pk2(o[0], o[1]); w.y = pk2(o[2], o[3]); w.z = pk2(o[4], o[5]); w.w = pk2(o[6], o[7]);
        *(LAS u32x4*)(lds + b * UROWB + t0 * 2) = w;
    }
}
__device__ __forceinline__ void hy_gate_inplace(LAS unsigned char* lds, const f32x16 (&acc)[8], int wave, int i32, int h) {
    LAS unsigned char* lp = lds + i32 * UROWB + (256 * wave + 4 * h) * 2;
#pragma unroll
    for (int r = 0; r < 8; ++r)
#pragma unroll
        for (int g = 0; g < 4; ++g) {
            LAS u32x2* up = (LAS u32x2*)(lp + (32 * r + 8 * g) * 2);
            const u32x2 uu = *up;
            u32x2 w; w.x = pk2(bf_lo(uu.x) * acc[r][4 * g + 0], bf_hi(uu.x) * acc[r][4 * g + 1]); w.y = pk2(bf_lo(uu.y) * acc[r][4 * g + 2], bf_hi(uu.y) * acc[r][4 * g + 3]);
            *up = w;
        }
}
__device__ __forceinline__ void hy_load_filter(LAS unsigned char* lds, const bf16_t* RF, int o, int c, int tid) {
    unsigned v[8];
#pragma unroll
    for (int j = 0; j < 8; ++j) {
        const int n = 8 * tid + j;
        const int dir = (n > 2048) ? 1 : 0, l = (n > 2048) ? n - 2048 : 2048 - n;
        const int ll = (l > 2047) ? 2047 : l;
        v[j] = RF[(size_t)ll * 2048 + (o * 2 + dir) * 512 + c];
        if (n == 0) v[j] = 0u;
    }
    u32x4 w; w.x = v[0] | (v[1] << 16); w.y = v[2] | (v[3] << 16); w.z = v[4] | (v[5] << 16); w.w = v[6] | (v[7] << 16);
    *(LAS u32x4*)(lds + HY_R_OFF + tid * 16) = w;
}
__device__ __forceinline__ void hyena_unit(const Params& p, LAS unsigned char* lds, int c, int tid, int wave, int lane) {
    const bf16_t* HYT = (const bf16_t*)(p.ws + WS_HYT); const bf16_t* RF = (const bf16_t*)(p.ws + WS_RF); bf16_t* ZT = (bf16_t*)(p.ws + WS_ZT);
    const float* cw = p.in[3]; const float* cb = p.in[4];
    asm volatile("" : "+v"(tid), "+v"(lane));
    int i32 = lane & 31, h = lane >> 5;
    hy_stage(lds, HYT + (size_t)c * NTOK, cw[c], cw[1536 + c], cw[3072 + c], cb[c], tid);
    hy_load_filter(lds, RF, 0, c, tid);
    if (tid < 4) *(LAS unsigned*)(lds + HY_R_OFF + 8192 + tid * 4) = 0u;
    __syncthreads();
    f32x16 acc[8];
    hy_conv(acc, lds, wave, i32, h);
    __syncthreads();
    asm volatile("" : "+v"(tid), "+v"(i32), "+v"(h));
    hy_stage(lds, HYT + (size_t)(512 + c) * NTOK, cw[512 + c], cw[1536 + 512 + c], cw[3072 + 512 + c], cb[512 + c], tid);
    hy_load_filter(lds, RF, 1, c, tid);
    __syncthreads();
    hy_gate_inplace(lds, acc, wave, i32, h);
    __syncthreads();
    hy_conv(acc, lds, wave, i32, h);
    __syncthreads();
    asm volatile("" : "+v"(tid), "+v"(i32), "+v"(h));
    hy_stage(lds, HYT + (size_t)(1024 + c) * NTOK, cw[1024 + c], cw[1536 + 1024 + c], cw[3072 + 1024 + c], cb[1024 + c], tid);
    __syncthreads();
    hy_gate_inplace(lds, acc, wave, i32, h);
    __syncthreads();
    {
        bf16_t* zt = ZT + (size_t)c * NTOK;
#pragma unroll 4
        for (int ch = tid; ch < 8192; ch += NTHREADS) {
            const int b = ch >> 8, t0 = (ch & 255) << 3;
            *(u32x4*)(zt + b * SEQ + t0) = *(const LAS u32x4*)(lds + b * UROWB + t0 * 2);
        }
    }
    __syncthreads();
}

constexpr int KROWB = 144;
constexpr int VROWB = 792;
constexpr int AT_V_OFF = 384 * KROWB;

__device__ __forceinline__ void attn_unit(const Params& p, LAS unsigned char* lds, int unit, int tid, int wave, int lane) {
    const bf16_t* proj = (const bf16_t*)(p.ws + WS_PROJ); const float* ROPE = (const float*)(p.ws + WS_ROPE); bf16_t* YA = (bf16_t*)(p.ws + WS_YA);
    const float* qg = p.in[14]; const float* kg = p.in[15]; const float* sink = p.in[16];
    const int b = unit >> 4, start = (unit & 15) * 128;
    asm volatile("" : "+v"(tid), "+v"(lane));
    const int i32 = lane & 31, h = lane >> 5;
    const float* RC = ROPE; const float* RS = ROPE + SEQ * 32;
    for (int kvh = 0; kvh < 2; ++kvh) {
#pragma unroll
        for (int task = tid; task < 1536; task += NTHREADS) {
            const int kk = task >> 2, c4 = task & 3, kp = start - 128 + kk;
            const bool valid = (kp >= 0) && (kp < SEQ);
            float x1[8], x2[8]; float ss = 0.f;
            if (valid) {
                const bf16_t* src = proj + (size_t)(b * SEQ + kp) * NPROJ + PJ_K + kvh * 64 + 8 * c4;
                const u32x4 a = *(const u32x4*)src, bq = *(const u32x4*)(src + 32);
                x1[0] = bf_lo(a.x); x1[1] = bf_hi(a.x); x1[2] = bf_lo(a.y); x1[3] = bf_hi(a.y); x1[4] = bf_lo(a.z); x1[5] = bf_hi(a.z); x1[6] = bf_lo(a.w); x1[7] = bf_hi(a.w);
                x2[0] = bf_lo(bq.x); x2[1] = bf_hi(bq.x); x2[2] = bf_lo(bq.y); x2[3] = bf_hi(bq.y); x2[4] = bf_lo(bq.z); x2[5] = bf_hi(bq.z); x2[6] = bf_lo(bq.w); x2[7] = bf_hi(bq.w);
#pragma unroll
                for (int j = 0; j < 8; ++j) ss += x1[j] * x1[j] + x2[j] * x2[j];
            } else {
#pragma unroll
                for (int j = 0; j < 8; ++j) { x1[j] = 0.f; x2[j] = 0.f; }
            }
            ss += __shfl_xor(ss, 1); ss += __shfl_xor(ss, 2);
            u32x4 o1 = {0u, 0u, 0u, 0u}, o2 = {0u, 0u, 0u, 0u};
            if (valid) {
                const float rstd = 1.0f / sqrtf(ss * (1.0f / 64.0f) + EPS);
                const f32x4 c0 = *(const f32x4*)(RC + kp * 32 + 8 * c4), c1 = *(const f32x4*)(RC + kp * 32 + 8 * c4 + 4);
                const f32x4 s0 = *(const f32x4*)(RS + kp * 32 + 8 * c4), s1 = *(const f32x4*)(RS + kp * 32 + 8 * c4 + 4);
                float r1[8], r2[8];
#pragma unroll
                for (int j = 0; j < 8; ++j) {
                    const float cc = (j < 4) ? c0[j & 3] : c1[j & 3], sn = (j < 4) ? s0[j & 3] : s1[j & 3];
                    const float a1 = x1[j] * rstd * kg[8 * c4 + j], a2 = x2[j] * rstd * kg[32 + 8 * c4 + j];
                    r1[j] = a1 * cc - a2 * sn; r2[j] = a2 * cc + a1 * sn;
                }
                o1.x = pk2(r1[0], r1[1]); o1.y = pk2(r1[2], r1[3]); o1.z = pk2(r1[4], r1[5]); o1.w = pk2(r1[6], r1[7]);
                o2.x = pk2(r2[0], r2[1]); o2.y = pk2(r2[2], r2[3]); o2.z = pk2(r2[4], r2[5]); o2.w = pk2(r2[6], r2[7]);
            }
            *(LAS u32x4*)(lds + kk * KROWB + 16 * c4) = o1;
            *(LAS u32x4*)(lds + kk * KROWB + 64 + 16 * c4) = o2;
        }
#pragma unroll
        for (int it = 0; it < 2; ++it) {
            const int task = tid + it * NTHREADS;
            if (task < 768) {
                const int kg = task >> 3, c8 = task & 7, kk = 4 * kg, kp = start - 128 + kk;
                u32x4 a0 = {0u, 0u, 0u, 0u}, a1 = a0, a2 = a0, a3 = a0;
                if (kp >= 0 && kp < SEQ) {
                    const bf16_t* src = proj + (size_t)(b * SEQ + kp) * NPROJ + PJ_V + kvh * 64 + 8 * c8;
                    a0 = *(const u32x4*)src; a1 = *(const u32x4*)(src + NPROJ); a2 = *(const u32x4*)(src + 2 * NPROJ); a3 = *(const u32x4*)(src + 3 * NPROJ);
                }
                LAS unsigned char* dst = lds + AT_V_OFF + (8 * c8) * VROWB + kk * 2;
#pragma unroll
                for (int w = 0; w < 4; ++w) {
                    u32x2 lo, hi;
                    lo.x = __builtin_amdgcn_perm(a1[w], a0[w], 0x05040100u); lo.y = __builtin_amdgcn_perm(a3[w], a2[w], 0x05040100u);
                    hi.x = __builtin_amdgcn_perm(a1[w], a0[w], 0x07060302u); hi.y = __builtin_amdgcn_perm(a3[w], a2[w], 0x07060302u);
                    *(LAS u32x2*)(dst + (2 * w) * VROWB) = lo;
                    *(LAS u32x2*)(dst + (2 * w + 1) * VROWB) = hi;
                }
            }
        }
        const int g = wave >> 1, half = wave & 1, hq = kvh * 4 + g, p0 = start + 64 * half;
        u32x4 qraw[2][4];
#pragma unroll
        for (int qt = 0; qt < 2; ++qt) {
            const bf16_t* src = proj + (size_t)(b * SEQ + p0 + 32 * qt + i32) * NPROJ + PJ_Q + hq * 64 + 8 * h;
#pragma unroll
            for (int ks = 0; ks < 4; ++ks) qraw[qt][ks] = *(const u32x4*)(src + 16 * ks);
        }
        __syncthreads();
        bf16x8 qf[2][4];
#pragma unroll
        for (int qt = 0; qt < 2; ++qt) {
            const int pos = p0 + 32 * qt + i32;
            float x[4][8]; float ss = 0.f;
#pragma unroll
            for (int ks = 0; ks < 4; ++ks) {
                const u32x4 a = qraw[qt][ks];
                x[ks][0] = bf_lo(a.x); x[ks][1] = bf_hi(a.x); x[ks][2] = bf_lo(a.y); x[ks][3] = bf_hi(a.y); x[ks][4] = bf_lo(a.z); x[ks][5] = bf_hi(a.z); x[ks][6] = bf_lo(a.w); x[ks][7] = bf_hi(a.w);
#pragma unroll
                for (int j = 0; j < 8; ++j) ss += x[ks][j] * x[ks][j];
            }
            ss += __shfl_xor(ss, 32);
            const float rstd = (0.125f * 1.4426950408889634f) / sqrtf(ss * (1.0f / 64.0f) + EPS);
#pragma unroll
            for (int ks = 0; ks < 2; ++ks) {
                const int d1 = 16 * ks + 8 * h;
                const f32x4 c0 = *(const f32x4*)(RC + pos * 32 + d1), c1 = *(const f32x4*)(RC + pos * 32 + d1 + 4);
                const f32x4 s0 = *(const f32x4*)(RS + pos * 32 + d1), s1 = *(const f32x4*)(RS + pos * 32 + d1 + 4);
#pragma unroll
                for (int j = 0; j < 8; ++j) {
                    const float cc = (j < 4) ? c0[j & 3] : c1[j & 3], sn = (j < 4) ? s0[j & 3] : s1[j & 3];
                    const float a1 = x[ks][j] * rstd * qg[d1 + j], a2 = x[ks + 2][j] * rstd * qg[d1 + 32 + j];
                    x[ks][j] = a1 * cc - a2 * sn; x[ks + 2][j] = a2 * cc + a1 * sn;
                }
            }
#pragma unroll
            for (int ks = 0; ks < 4; ++ks) {
                u32x4 w; w.x = pk2(x[ks][0], x[ks][1]); w.y = pk2(x[ks][2], x[ks][3]); w.z = pk2(x[ks][4], x[ks][5]); w.w = pk2(x[ks][6], x[ks][7]);
                qf[qt][ks] = __builtin_bit_cast(bf16x8, w);
            }
        }
        const float sink2 = sink[hq] * 1.4426950408889634f;
        float mrun[2] = {sink2, sink2}, lrun[2] = {1.0f, 1.0f};
        f32x16 o[2][2];
#pragma unroll
        for (int a = 0; a < 2; ++a)
#pragma unroll
            for (int c = 0; c < 2; ++c)
#pragma unroll
                for (int i = 0; i < 16; ++i) o[a][c][i] = 0.f;
        for (int jt = 0; jt < 5; ++jt) {
            const int kk0 = 64 * half + 64 * jt, kp0 = start - 128 + kk0;
            if (kp0 + 63 < 0 || kp0 >= SEQ) continue;
            const bool need_mask = (jt == 0) || (jt == 4) || (kp0 < 0) || (kp0 + 64 > SEQ);
            f32x16 st[2][2];
#pragma unroll
            for (int a = 0; a < 2; ++a)
#pragma unroll
                for (int c = 0; c < 2; ++c)
#pragma unroll
                    for (int i = 0; i < 16; ++i) st[a][c][i] = 0.f;
#pragma unroll
            for (int ks = 0; ks < 4; ++ks) {
                const bf16x8 kf0 = *(const LAS bf16x8*)(lds + (kk0 + i32) * KROWB + (16 * ks + 8 * h) * 2);
                const bf16x8 kf1 = *(const LAS bf16x8*)(lds + (kk0 + 32 + i32) * KROWB + (16 * ks + 8 * h) * 2);
#pragma unroll
                for (int qt = 0; qt < 2; ++qt) { st[0][qt] = MFMA32(kf0, qf[qt][ks], st[0][qt]); st[1][qt] = MFMA32(kf1, qf[qt][ks], st[1][qt]); }
            }
#pragma unroll
            for (int qt = 0; qt < 2; ++qt) {
                const int qpos = p0 + 32 * qt + i32;
                float mx = -INFINITY;
#pragma unroll
                for (int mt = 0; mt < 2; ++mt)
#pragma unroll
                    for (int i = 0; i < 16; ++i) {
                        float s = st[mt][qt][i];
                        if (need_mask) {
                            const int kp = kp0 + 32 * mt + (i & 3) + 8 * (i >> 2) + 4 * h;
                            const int dlt = kp - qpos;
                            const bool ok = (kp >= 0) && (kp < SEQ) && (dlt <= 128) && (dlt >= -128);
                            s = ok ? s : -INFINITY;
                            st[mt][qt][i] = s;
                        }
                        mx = fmaxf(mx, s);
                    }
                mx = fmaxf(mx, __shfl_xor(mx, 32));
                const float mnew = fmaxf(mrun[qt], mx);
                const float alpha = __builtin_amdgcn_exp2f(mrun[qt] - mnew);
                mrun[qt] = mnew;
                float rs = 0.f;
#pragma unroll
                for (int mt = 0; mt < 2; ++mt)
#pragma unroll
                    for (int i = 0; i < 16; ++i) { const float pv = __builtin_amdgcn_exp2f(st[mt][qt][i] - mnew); st[mt][qt][i] = pv; rs += pv; }
                rs += __shfl_xor(rs, 32);
                lrun[qt] = lrun[qt] * alpha + rs;
#pragma unroll
                for (int i = 0; i < 16; ++i) { o[0][qt][i] *= alpha; o[1][qt][i] *= alpha; }
            }
#pragma unroll
            for (int mt = 0; mt < 2; ++mt)
#pragma unroll
                for (int s2 = 0; s2 < 2; ++s2) {
                    bf16x8 pf[2];
#pragma unroll
                    for (int qt = 0; qt < 2; ++qt) {
                        u32x4 w; w.x = pk2(st[mt][qt][8 * s2 + 0], st[mt][qt][8 * s2 + 1]); w.y = pk2(st[mt][qt][8 * s2 + 2], st[mt][qt][8 * s2 + 3]);
                        w.z = pk2(st[mt][qt][8 * s2 + 4], st[mt][qt][8 * s2 + 5]); w.w = pk2(st[mt][qt][8 * s2 + 6], st[mt][qt][8 * s2 + 7]);
                        pf[qt] = __builtin_bit_cast(bf16x8, w);
                    }
                    const int kb = kk0 + 32 * mt + 16 * s2 + 4 * h;
#pragma unroll
                    for (int dt = 0; dt < 2; ++dt) {
                        const LAS unsigned char* vp = lds + AT_V_OFF + (32 * dt + i32) * VROWB + kb * 2;
                        const u32x2 lo = *(const LAS u32x2*)vp, hi = *(const LAS u32x2*)(vp + 16);
                        u32x4 w; w.x = lo.x; w.y = lo.y; w.z = hi.x; w.w = hi.y;
                        const bf16x8 vf = __builtin_bit_cast(bf16x8, w);
#pragma unroll
                        for (int qt = 0; qt < 2; ++qt) o[dt][qt] = MFMA32(vf, pf[qt], o[dt][qt]);
                    }
                }
        }
#pragma unroll
        for (int qt = 0; qt < 2; ++qt) {
            const float inv = 1.0f / lrun[qt];
            bf16_t* dst = YA + (size_t)(b * SEQ + p0 + 32 * qt + i32) * DH + hq * 64 + 4 * h;
#pragma unroll
            for (int dt = 0; dt < 2; ++dt)
#pragma unroll
                for (int g4 = 0; g4 < 4; ++g4) {
                    u32x2 w; w.x = pk2(o[dt][qt][4 * g4 + 0] * inv, o[dt][qt][4 * g4 + 1] * inv); w.y = pk2(o[dt][qt][4 * g4 + 2] * inv, o[dt][qt][4 * g4 + 3] * inv);
                    *(u32x2*)(dst + 32 * dt + 8 * g4) = w;
                }
        }
        __syncthreads();
    }
}

constexpr int TROWB = 1028;
__device__ __forceinline__ void p3_unit(const Params& p, LAS unsigned char* lds, int unit, int tid, int wave, int lane) {
    const bf16_t* ZT = (const bf16_t*)(p.ws + WS_ZT); const bf16_t* YA = (const bf16_t*)(p.ws + WS_YA); const bf16_t* proj = (const bf16_t*)(p.ws + WS_PROJ);
    bf16_t* Y = (bf16_t*)(p.ws + WS_Y);
    const int tok0 = unit * 64;
#pragma unroll 4
    for (int task = tid; task < 4096; task += NTHREADS) {
        const int c = task >> 3, ch = task & 7;
        const u32x4 v = *(const u32x4*)(ZT + (size_t)c * NTOK + tok0 + 8 * ch);
        LAS unsigned char* dst = lds + (8 * ch) * TROWB + 2 * c;
        *(LAS bf16_t*)(dst + 0 * TROWB) = (bf16_t)(v.x & 0xffffu); *(LAS bf16_t*)(dst + 1 * TROWB) = (bf16_t)(v.x >> 16);
        *(LAS bf16_t*)(dst + 2 * TROWB) = (bf16_t)(v.y & 0xffffu); *(LAS bf16_t*)(dst + 3 * TROWB) = (bf16_t)(v.y >> 16);
        *(LAS bf16_t*)(dst + 4 * TROWB) = (bf16_t)(v.z & 0xffffu); *(LAS bf16_t*)(dst + 5 * TROWB) = (bf16_t)(v.z >> 16);
        *(LAS bf16_t*)(dst + 6 * TROWB) = (bf16_t)(v.w & 0xffffu); *(LAS bf16_t*)(dst + 7 * TROWB) = (bf16_t)(v.w >> 16);
    }
    __syncthreads();
    for (int half = 0; half < 2; ++half) {
        unsigned zh[4][4], gh4[4][4], za[4][4], ga4[4][4];
#pragma unroll
        for (int q = 0; q < 4; ++q) {
            const int tt = wave + 8 * (4 * half + q); const size_t token = (size_t)(tok0 + tt);
            const LAS unsigned* rw = (const LAS unsigned*)(lds + tt * TROWB);
            const unsigned* gh = (const unsigned*)(proj + token * NPROJ + PJ_GH); const unsigned* ga = (const unsigned*)(proj + token * NPROJ + PJ_GA);
            const unsigned* ya = (const unsigned*)(YA + token * DH);
#pragma unroll
            for (int k = 0; k < 4; ++k) { zh[q][k] = rw[lane + 64 * k]; gh4[q][k] = gh[lane + 64 * k]; za[q][k] = ya[lane + 64 * k]; ga4[q][k] = ga[lane + 64 * k]; }
        }
#pragma unroll
        for (int q = 0; q < 4; ++q) {
            const int tt = wave + 8 * (4 * half + q); const size_t token = (size_t)(tok0 + tt);
            float ssh = 0.f, ssa = 0.f;
#pragma unroll
            for (int k = 0; k < 4; ++k) { const float a = bf_lo(zh[q][k]), bq = bf_hi(zh[q][k]), c2 = bf_lo(za[q][k]), d2 = bf_hi(za[q][k]); ssh += a * a + bq * bq; ssa += c2 * c2 + d2 * d2; }
            const float rh = 1.0f / sqrtf(wave_sum(ssh) * (1.0f / 512.0f) + EPS), ra = 1.0f / sqrtf(wave_sum(ssa) * (1.0f / 512.0f) + EPS);
            unsigned* yo = (unsigned*)(Y + token * DM);
#pragma unroll
            for (int k = 0; k < 4; ++k) {
                yo[lane + 64 * k] = pk2(bf_lo(zh[q][k]) * rh * silu_f(bf_lo(gh4[q][k])), bf_hi(zh[q][k]) * rh * silu_f(bf_hi(gh4[q][k])));
                yo[256 + lane + 64 * k] = pk2(bf_lo(za[q][k]) * ra * silu_f(bf_lo(ga4[q][k])), bf_hi(za[q][k]) * ra * silu_f(bf_hi(ga4[q][k])));
            }
        }
    }
    __syncthreads();
}

__device__ __forceinline__ void grid_bar(unsigned* ctr, unsigned target) {
    asm volatile("s_waitcnt vmcnt(0) lgkmcnt(0)" ::: "memory");
    __syncthreads();
    if (threadIdx.x == 0) {
        __builtin_amdgcn_fence(__ATOMIC_RELEASE, "agent");
        asm volatile("s_waitcnt vmcnt(0)" ::: "memory");
        __hip_atomic_fetch_add(ctr, 1u, __ATOMIC_RELAXED, __HIP_MEMORY_SCOPE_AGENT);
        while (__hip_atomic_load(ctr, __ATOMIC_RELAXED, __HIP_MEMORY_SCOPE_AGENT) < target) __builtin_amdgcn_s_sleep(1);
        __builtin_amdgcn_fence(__ATOMIC_ACQUIRE, "agent");
        asm volatile("s_waitcnt vmcnt(0)" ::: "memory");
    }
    __syncthreads();
}

__global__ void __launch_bounds__(NTHREADS) hymba_fwd(Params p) {
    extern __shared__ __attribute__((aligned(16))) unsigned char lds_raw[];
    LAS unsigned char* lds = (LAS unsigned char*)lds_raw;
    cg::grid_group grid = cg::this_grid();
    unsigned* ctl = (unsigned*)(p.ws + WS_CTL);
    int tid = threadIdx.x, lane = tid & 63, wave = __builtin_amdgcn_readfirstlane(tid >> 6);
#define FRESH_IDS() do { tid = threadIdx.x; asm volatile("" : "+v"(tid)); lane = tid & 63; wave = __builtin_amdgcn_readfirstlane(tid >> 6); } while (0)

    if (blockIdx.x == 0 && tid < 3) __hip_atomic_store(ctl + 64 * tid, 0u, __ATOMIC_RELAXED, __HIP_MEMORY_SCOPE_AGENT);
    p0_prologue(p, lds, tid, wave, lane);
    grid.sync();
    FRESH_IDS();
    {
        pg8::Gemm g{(const bf16_t*)(p.ws + WS_XB), (const bf16_t*)(p.ws + WS_WIN), NTOK, NIN, DM};
        pg8::StaticOrder S; S.init(NTOK, NIN, (int)gridDim.x, (int)blockIdx.x);
        EpiIn E{(bf16_t*)(p.ws + WS_HYT), (bf16_t*)(p.ws + WS_PROJ)};
        pg8::gemm_phase2<EpiIn, pg8::StaticOrder, GEMM_ALIGN, GEMM_SP2>(lds, g, S, E);
    }
    grid_bar(ctl + 0, gridDim.x);
    FRESH_IDS();
    {
        const int vcu = ((gridDim.x & 7) == 0) ? (int)((blockIdx.x & 7) * (gridDim.x >> 3) + (blockIdx.x >> 3)) : (int)blockIdx.x;
        for (int u = vcu; u < NB * 16; u += gridDim.x) attn_unit(p, lds, u, tid, wave, lane);
    }
    FRESH_IDS();
    {
        const int vcu = ((gridDim.x & 7) == 0) ? (int)((blockIdx.x & 7) * (gridDim.x >> 3) + (blockIdx.x >> 3)) : (int)blockIdx.x;
        for (int u = vcu; u < DH; u += gridDim.x) hyena_unit(p, lds, u, tid, wave, lane);
    }
    grid_bar(ctl + 64, gridDim.x);
    FRESH_IDS();
    {
        LAS float* scr = (LAS float*)(lds + wave * 16384);
        bf16_t* WoutT = (bf16_t*)(p.ws + WS_WOUT);
#pragma unroll 1
        for (int it = blockIdx.x * 8 + wave; it < (DM / 64) * (DM / 32); it += gridDim.x * 8) {
            const int kb = it / (DM / 32);
            p0_transpose_item(p.in[19], (kb < 8) ? p.in[17] : (p.in[18] - 512), DM, DM, WoutT, scr, it, lane);
        }
        __syncthreads();
    }
    for (int u = blockIdx.x; u < NTOK / 64; u += gridDim.x) p3_unit(p, lds, u, tid, wave, lane);
    grid_bar(ctl + 128, gridDim.x);
    FRESH_IDS();
    {
        pg8::Gemm g{(const bf16_t*)(p.ws + WS_Y), (const bf16_t*)(p.ws + WS_WOUT), NTOK, DM, DM};
        pg8::StaticOrder S; S.init(NTOK, DM, (int)gridDim.x, (int)blockIdx.x);
        EpiOut E{p.in[0], p.out};
        pg8::gemm_phase2<EpiOut, pg8::StaticOrder, GEMM_ALIGN, GEMM_SP2>(lds, g, S, E);
    }
}

extern "C" void kernel_launch(void* const* d_in, const int* in_sizes, int n_in, void* d_out, int out_size, void* d_ws, size_t ws_size, hipStream_t stream) {
    static int grid = 0;
    if (grid == 0) {
        if (n_in != 20 || ws_size < WS_END) { fprintf(stderr, "kernel_launch: unexpected inputs (n_in %d, ws %zu < %zu)\n", n_in, ws_size, (size_t)WS_END); grid = -1; return; }
        int dev = 0, cus = 0, per_cu = 0;
        hipGetDevice(&dev);
        hipDeviceGetAttribute(&cus, hipDeviceAttributeMultiprocessorCount, dev);
        if (hipFuncSetAttribute((const void*)hymba_fwd, hipFuncAttributeMaxDynamicSharedMemorySize, LDS_BYTES) != hipSuccess) fprintf(stderr, "kernel_launch: hipFuncSetAttribute failed\n");
        if (hipOccupancyMaxActiveBlocksPerMultiprocessor(&per_cu, (const void*)hymba_fwd, NTHREADS, LDS_BYTES) != hipSuccess || per_cu < 1) { fprintf(stderr, "kernel_launch: occupancy query gave %d\n", per_cu); per_cu = 1; }
        (void)hipGetLastError();
        grid = cus * (per_cu > 1 ? 1 : per_cu);
        if (grid > 256) grid = 256;
    }
    if (grid < 0) return;
    Params p{};
    for (int i = 0; i < 20; ++i) p.in[i] = (const float*)d_in[i];
    p.out = (float*)d_out; p.ws = (unsigned char*)d_ws;
    void* args[] = {&p};
    hipError_t e = hipLaunchCooperativeKernel((const void*)hymba_fwd, dim3(grid), dim3(NTHREADS), args, LDS_BYTES, stream);
    if (e != hipSuccess) fprintf(stderr, "cooperative launch failed: %s (grid %d)\n", hipGetErrorString(e), grid);
}
```

```cpp
#include <hip/hip_runtime.h>
#include <hip/hip_cooperative_groups.h>
#include <cstdio>
namespace cg = cooperative_groups;
namespace pg8 {
#define PG8_LAS __attribute__((address_space(3)))
typedef unsigned short bf16_t;
typedef short bf16x8 __attribute__((ext_vector_type(8)));
typedef float f32x4 __attribute__((ext_vector_type(4)));
typedef unsigned u32x4 __attribute__((ext_vector_type(4)));
constexpr int BM = 256, BK = 64, HALF = 128, HTB = HALF * BK * 2  , STAGE_BYTES = 8 * HTB, NXCD = 8, WGM = 4;

__host__ __device__ __forceinline__ int lds_byte(int r, int c) { const int st = (r >> 4) * 2 + (c >> 5), rr = r & 15, cc = c & 31, ob = rr * 64 + cc * 2; return st * 1024 + (ob ^ (((ob >> 9) & 1) << 5)); }
__host__ __device__ __forceinline__ void stage_rc(int b, int& R, int& C) { const int st = b / 1024, sb = b % 1024, swz = sb ^ (((sb >> 9) & 1) << 5); R = (st >> 1) * 16 + swz / 64; C = (st & 1) * 32 + (swz % 64) / 2; }
__host__ __device__ __forceinline__ int perm32(int rho) { const int n = rho >> 4, i = rho & 15; return 8 * (i >> 2) + 4 * n + (i & 3); }

struct Unit { int pm, pn; };
struct Gemm { const bf16_t* A; const bf16_t* Bt; int M, N, K; };

struct StaticOrder {
    int nM, nN, nwg, G, c;
    __host__ __device__ void init(int M, int N, int G_, int c_) { nM = M / BM; nN = N / BM; nwg = nM * nN; G = G_; c = c_; }
    __host__ __device__ bool next(int i, Unit& u) const {
        const long L = (long)i * G + c; if (L >= nwg) return false;
        int wgid = (int)L; { const int q = nwg / NXCD, r = nwg % NXCD, xcd = wgid % NXCD, off = wgid / NXCD; wgid = (xcd < r ? xcd * (q + 1) : r * (q + 1) + (xcd - r) * q) + off; }
        const int nig = WGM * nN, gid = wgid / nig, fm = gid * WGM, gsz = (nM - fm) < WGM ? (nM - fm) : WGM;
        u.pm = fm + ((wgid % nig) % gsz); u.pn = (wgid % nig) / gsz; return true;
    }
    __device__ __forceinline__ void a_ready(const Unit&) const {}
    __device__ __forceinline__ void done(const Unit&) const {}
};

template <class Epi, class Sched, bool ALIGN_EPI = false, bool SP2 = false>
__device__ __forceinline__ void gemm_phase2(PG8_LAS unsigned char* lds, const Gemm g, const Sched& S, const Epi& E) {
    int tid_raw = threadIdx.x; asm volatile("" : "+v"(tid_raw));
    const int tid = tid_raw, wid = __builtin_amdgcn_readfirstlane(tid >> 6), lane = tid & 63, wr = wid >> 2, wc = wid & 3, fr = lane & 15, fq = lane >> 4;
    const int K = g.K, nt = K / BK;
    unsigned voffA[2], voffB[2];
#pragma unroll
    for (int i = 0; i < 2; ++i) { int R, C; stage_rc(tid * 16 + i * 8192, R, C); const int Rb = Epi::PERM ? ((R & ~31) + perm32(R & 31)) : R;
        const int Ra = Epi::APERM ? (128 * (R >> 6) + 8 * (R & 15) + ((R >> 4) & 3)) : R; voffA[i] = (unsigned)(Ra * K + C) * 2u; voffB[i] = (unsigned)(Rb * K + C) * 2u; }
    const size_t kstep = (size_t)(BK * 2);
    const size_t hstep = (size_t)HALF * K * 2;
    const size_t tstep = 2 * hstep;
    const size_t hstepA = Epi::APERM ? (size_t)4 * K * 2 : hstep;
    const unsigned ldsw = (unsigned)wid * 1024u;
    const int aoff = lds_byte(wr * 64 + fr, fq * 8), boff = lds_byte(wc * 32 + fr, fq * 8);
#define PG8_SA(b, h) (((b) * 2 + (h)) * HTB)
#define PG8_SB(b, h) ((4 + (b) * 2 + (h)) * HTB)
#define PG8_STAGE(bufoff, gbase, voff) do { _Pragma("unroll") for (int _i = 0; _i < 2; ++_i) \
        __builtin_amdgcn_global_load_lds((const unsigned*)((const char*)(gbase) + (voff)[_i]), (PG8_LAS unsigned*)(lds + (bufoff) + ldsw + _i * 8192), 16, 0, 0); } while (0)
#define PG8_LDA(dst, b, h) do { _Pragma("unroll") for (int m = 0; m < 4; ++m) _Pragma("unroll") for (int k = 0; k < 2; ++k) dst[m][k] = *(const PG8_LAS bf16x8*)(lds + PG8_SA(b, h) + aoff + m * 2048 + k * 1024); } while (0)
#define PG8_LDB(dst, b, h) do { _Pragma("unroll") for (int n = 0; n < 2; ++n) _Pragma("unroll") for (int k = 0; k < 2; ++k) dst[n][k] = *(const PG8_LAS bf16x8*)(lds + PG8_SB(b, h) + boff + n * 2048 + k * 1024); } while (0)
#define PG8_MMA(ai, bj, At, Bt) do { __builtin_amdgcn_s_setprio(1); _Pragma("unroll") for (int m = 0; m < 4; ++m) _Pragma("unroll") for (int n = 0; n < 2; ++n) _Pragma("unroll") for (int k = 0; k < 2; ++k) \
        acc[ai][bj][m][n] = __builtin_amdgcn_mfma_f32_16x16x32_bf16(Bt[n][k], At[m][k], acc[ai][bj][m][n], 0, 0, 0); __builtin_amdgcn_s_setprio(0); } while (0)
#define PG8_WAIT_V(n) asm volatile("s_waitcnt vmcnt(" #n ")" ::: "memory")
#define PG8_WAIT_L(n) asm volatile("s_waitcnt lgkmcnt(" #n ")" ::: "memory")
#define PG8_BAR __builtin_amdgcn_s_barrier()
#define PG8_SCHED __builtin_amdgcn_sched_barrier(0)
    Unit cur, nxt; int ui = 0;
    if (!S.next(0, cur)) return;
    f32x4 acc[2][2][4][2];
#pragma unroll
    for (int a = 0; a < 2; ++a)
#pragma unroll
        for (int b = 0; b < 2; ++b)
#pragma unroll
            for (int m = 0; m < 4; ++m)
#pragma unroll
                for (int n = 0; n < 2; ++n) acc[a][b][m][n] = (f32x4){0.f, 0.f, 0.f, 0.f};
    bf16x8 At[4][2], B0[2][2], B1[2][2];
    const char* cA = (const char*)g.A + (size_t)cur.pm * tstep; const char* cB = (const char*)g.Bt + (size_t)cur.pn * tstep;
    S.a_ready(cur);
    if constexpr (SP2) {
        PG8_STAGE(PG8_SB(0, 0), cB, voffB); PG8_STAGE(PG8_SB(0, 1), cB + hstep, voffB); PG8_STAGE(PG8_SA(0, 0), cA, voffA); PG8_STAGE(PG8_SA(0, 1), cA + hstepA, voffA);
        if (wr == 1) PG8_BAR;
        PG8_WAIT_V(2); PG8_BAR;
        PG8_STAGE(PG8_SB(1, 0), cB + kstep, voffB); PG8_STAGE(PG8_SA(1, 0), cA + kstep, voffA); PG8_STAGE(PG8_SB(1, 1), cB + hstep + kstep, voffB);
        PG8_WAIT_V(6); PG8_BAR;
    } else {
        PG8_STAGE(PG8_SB(0, 0), cB, voffB); PG8_STAGE(PG8_SA(0, 0), cA, voffA); PG8_STAGE(PG8_SB(0, 1), cB + hstep, voffB); PG8_STAGE(PG8_SA(0, 1), cA + hstepA, voffA);
        if (wr == 1) PG8_BAR;
        PG8_WAIT_V(4); PG8_BAR;
        PG8_STAGE(PG8_SB(1, 0), cB + kstep, voffB); PG8_STAGE(PG8_SA(1, 0), cA + kstep, voffA); PG8_STAGE(PG8_SB(1, 1), cB + hstep + kstep, voffB);
        PG8_WAIT_V(6); PG8_BAR;
    }
    for (;;) {
        const bool has_next = S.next(ui + 1, nxt);
        const char* nA = has_next ? (const char*)g.A + (size_t)nxt.pm * tstep : cA; const char* nB = has_next ? (const char*)g.Bt + (size_t)nxt.pn * tstep : cB;
        for (int t = 0; t < nt; t += 2) {
            const bool last = (t == nt - 2);
            const char* a1 = cA + (size_t)(t + 1) * kstep;
            const char* a2 = last ? nA : cA + (size_t)(t + 2) * kstep; const char* b2 = last ? nB : cB + (size_t)(t + 2) * kstep;
            const char* a3 = a2 + kstep; const char* b3 = b2 + kstep;
            if (last && has_next) S.a_ready(nxt);
            if constexpr (SP2) {
            PG8_LDB(B0, 0, 0); PG8_LDB(B1, 0, 1); PG8_SCHED; PG8_LDA(At, 0, 0); PG8_STAGE(PG8_SA(1, 1), a1 + hstepA, voffA);
            PG8_WAIT_V(8); PG8_WAIT_L(0); PG8_BAR; PG8_MMA(0, 0, At, B0); PG8_MMA(0, 1, At, B1); PG8_BAR; PG8_SCHED;
            PG8_LDA(At, 0, 1); PG8_STAGE(PG8_SB(0, 0), b2, voffB); PG8_STAGE(PG8_SB(0, 1), b2 + hstep, voffB); PG8_STAGE(PG8_SA(0, 0), a2, voffA);
            PG8_WAIT_V(8); PG8_WAIT_L(0); PG8_BAR; PG8_MMA(1, 0, At, B0); PG8_MMA(1, 1, At, B1); PG8_BAR; PG8_SCHED;
            PG8_LDB(B0, 1, 0); PG8_LDB(B1, 1, 1); PG8_SCHED; PG8_LDA(At, 1, 0); PG8_STAGE(PG8_SA(0, 1), a2 + hstepA, voffA);
            PG8_WAIT_V(8); PG8_WAIT_L(0); PG8_BAR; PG8_MMA(0, 0, At, B0); PG8_MMA(0, 1, At, B1); PG8_BAR; PG8_SCHED;
            PG8_LDA(At, 1, 1); PG8_STAGE(PG8_SB(1, 0), b3, voffB); PG8_STAGE(PG8_SB(1, 1), b3 + hstep, voffB); PG8_STAGE(PG8_SA(1, 0), a3, voffA);
            PG8_WAIT_V(8); PG8_WAIT_L(0); PG8_BAR; PG8_MMA(1, 0, At, B0); PG8_MMA(1, 1, At, B1); PG8_BAR; PG8_SCHED;
            } else {
            PG8_LDB(B0, 0, 0); PG8_SCHED; PG8_LDA(At, 0, 0); PG8_STAGE(PG8_SA(1, 1), a1 + hstepA, voffA);
            PG8_WAIT_L(8); PG8_BAR; PG8_WAIT_L(0); PG8_MMA(0, 0, At, B0); PG8_BAR; PG8_SCHED;
            PG8_LDB(B1, 0, 1); PG8_STAGE(PG8_SB(0, 0), b2, voffB);
            PG8_BAR; PG8_WAIT_L(0); PG8_MMA(0, 1, At, B1); PG8_BAR;
            PG8_LDA(At, 0, 1); PG8_STAGE(PG8_SA(0, 0), a2, voffA);
            PG8_BAR; PG8_WAIT_L(0); PG8_MMA(1, 0, At, B0); PG8_BAR; PG8_SCHED;
            PG8_STAGE(PG8_SB(0, 1), b2 + hstep, voffB);
            PG8_WAIT_V(6); PG8_BAR; PG8_MMA(1, 1, At, B1); PG8_BAR;
            PG8_LDB(B0, 1, 0); PG8_SCHED; PG8_LDA(At, 1, 0); PG8_STAGE(PG8_SA(0, 1), a2 + hstepA, voffA);
            PG8_WAIT_L(8); PG8_BAR; PG8_WAIT_L(0); PG8_MMA(0, 0, At, B0); PG8_BAR; PG8_SCHED;
            PG8_LDB(B1, 1, 1); PG8_STAGE(PG8_SB(1, 0), b3, voffB);
            PG8_BAR; PG8_WAIT_L(0); PG8_MMA(0, 1, At, B1); PG8_BAR;
            PG8_LDA(At, 1, 1); PG8_STAGE(PG8_SA(1, 0), a3, voffA);
            PG8_BAR; PG8_WAIT_L(0); PG8_MMA(1, 0, At, B0); PG8_BAR; PG8_SCHED;
            PG8_STAGE(PG8_SB(1, 1), b3 + hstep, voffB);
            PG8_WAIT_V(6); PG8_BAR; PG8_MMA(1, 1, At, B1); PG8_BAR;
            }
        }
        if constexpr (ALIGN_EPI) { if (wr == 0) PG8_BAR; }
        if constexpr (!Epi::AFTER_DRAIN) { E(acc, cur, wr, wc, fr, fq); S.done(cur); }
        if (!has_next) break;
#pragma unroll
        for (int a = 0; a < 2; ++a)
#pragma unroll
            for (int b = 0; b < 2; ++b)
#pragma unroll
                for (int m = 0; m < 4; ++m)
#pragma unroll
                    for (int n = 0; n < 2; ++n) acc[a][b][m][n] = (f32x4){0.f, 0.f, 0.f, 0.f};
        cur = nxt; cA = nA; cB = nB; ++ui;
        if constexpr (ALIGN_EPI) { if (wr == 1) PG8_BAR; }
    }
    PG8_WAIT_V(0);
    if constexpr (!ALIGN_EPI) { if (wr == 0) PG8_BAR; }
    PG8_BAR;
    if constexpr (Epi::AFTER_DRAIN) { E.fused(acc, cur, wr, wc, fr, fq, lds, wid, lane); S.done(cur); }
#undef PG8_SA
#undef PG8_SB
#undef PG8_STAGE
#undef PG8_LDA
#undef PG8_LDB
#undef PG8_MMA
#undef PG8_WAIT_V
#undef PG8_WAIT_L
#undef PG8_BAR
#undef PG8_SCHED
}
}

#define LAS __attribute__((address_space(3)))
using pg8::bf16_t; using pg8::bf16x8; using pg8::f32x4; using pg8::u32x4;
typedef float f32x16 __attribute__((ext_vector_type(16)));
typedef unsigned u32x2 __attribute__((ext_vector_type(2)));
typedef __bf16 bf2_t __attribute__((ext_vector_type(2)));
typedef float f32x2 __attribute__((ext_vector_type(2)));

constexpr int NB = 32, SEQ = 2048, DM = 1024, NTOK = NB * SEQ, NIN = 3328, DH = 512, NPROJ = 1792;
constexpr int PJ_GH = 0, PJ_Q = 512, PJ_K = 1024, PJ_V = 1152, PJ_GA = 1280;
constexpr float EPS = 1e-6f;
constexpr size_t WS_WIN = 0;
constexpr size_t WS_WOUT = WS_WIN + (size_t)NIN * DM * 2;
constexpr size_t WS_RF = WS_WOUT + (size_t)DM * DM * 2;
constexpr size_t WS_ROPE = WS_RF + (size_t)2 * DH * 4096 * 2;
constexpr size_t WS_XB = WS_ROPE + (size_t)SEQ * 32 * 4 * 2;
constexpr size_t WS_HYT = WS_XB + (size_t)NTOK * DM * 2;
constexpr size_t WS_PROJ = WS_HYT + (size_t)1536 * NTOK * 2;
constexpr size_t WS_ZT = WS_PROJ + (size_t)NTOK * NPROJ * 2;
constexpr size_t WS_YA = WS_ZT + (size_t)DH * NTOK * 2;
constexpr size_t WS_Y = WS_YA + (size_t)NTOK * DH * 2;
constexpr size_t WS_CTL = WS_Y + (size_t)NTOK * DM * 2;
constexpr size_t WS_END = WS_CTL + 4096;
constexpr int LDS_BYTES = 144 * 1024;
constexpr int NTHREADS = 512;
#ifndef GEMM_ALIGN
#define GEMM_ALIGN true
#endif
#ifndef GEMM_SP2
#define GEMM_SP2 true
#endif

#define LDS_WAIT() asm volatile("s_waitcnt lgkmcnt(0)" ::: "memory")
#define MFMA32(a, b, c) __builtin_amdgcn_mfma_f32_32x32x16_bf16((a), (b), (c), 0, 0, 0)

__device__ __forceinline__ unsigned pk2(float lo, float hi) { f32x2 v = {lo, hi}; bf2_t b = __builtin_convertvector(v, bf2_t); return __builtin_bit_cast(unsigned, b); }
__device__ __forceinline__ float bf_lo(unsigned w) { return __uint_as_float(w << 16); }
__device__ __forceinline__ float bf_hi(unsigned w) { return __uint_as_float(w & 0xffff0000u); }
__device__ __forceinline__ float bf1(bf16_t v) { return __uint_as_float(((unsigned)v) << 16); }
__device__ __forceinline__ float wave_sum(float v) {
#pragma unroll
    for (int o = 1; o < 64; o <<= 1) v += __shfl_xor(v, o);
    return v;
}

__device__ __forceinline__ float sin_acc(float x) { double r = (double)x * 0.15915494309189535; r -= rint(r); return __builtin_amdgcn_sinf((float)r); }
__device__ __forceinline__ float cos_acc(float x) { double r = (double)x * 0.15915494309189535; r -= rint(r); return __builtin_amdgcn_cosf((float)r); }
__device__ __forceinline__ float silu_f(float v) { return v * __builtin_amdgcn_rcpf(1.0f + __expf(-v)); }

struct EpiIn {
    static constexpr bool PERM = true, APERM = true, AFTER_DRAIN = false;
    bf16_t* hyt; bf16_t* proj;
    __device__ __forceinline__ void prefetch(const pg8::Unit&, int, float (&)[4]) const {}
    __device__ __forceinline__ void prefetch_done(float (&)[4]) const {}
    __device__ __forceinline__ void operator()(const f32x4 (&acc)[2][2][4][2], const pg8::Unit& u, int wr, int wc, int fr, int fq) const {
        const int tok0 = u.pm * 256 + wr * 128 + 8 * fr;
        if (u.pn < 6) {
            const int col0 = u.pn * 256 + wc * 32 + 8 * fq;
#pragma unroll
            for (int bj = 0; bj < 2; ++bj)
#pragma unroll
                for (int n = 0; n < 2; ++n)
#pragma unroll
                    for (int j = 0; j < 4; ++j) {
                        const int col = col0 + bj * 128 + 4 * n + j;
                        u32x4 w;
                        w.x = pk2(acc[0][bj][0][n][j], acc[0][bj][1][n][j]); w.y = pk2(acc[0][bj][2][n][j], acc[0][bj][3][n][j]);
                        w.z = pk2(acc[1][bj][0][n][j], acc[1][bj][1][n][j]); w.w = pk2(acc[1][bj][2][n][j], acc[1][bj][3][n][j]);
                        *(u32x4*)(hyt + (size_t)col * NTOK + tok0) = w;
                    }
        } else {
            const int pc0 = u.pn * 256 - 1536 + wc * 32 + 8 * fq;
#pragma unroll
            for (int ai = 0; ai < 2; ++ai)
#pragma unroll
                for (int m = 0; m < 4; ++m) {
                    bf16_t* rowp = proj + (size_t)(tok0 + 4 * ai + m) * NPROJ + pc0;
#pragma unroll
                    for (int bj = 0; bj < 2; ++bj) {
                        const f32x4 v0 = acc[ai][bj][m][0], v1 = acc[ai][bj][m][1];
                        u32x4 w; w.x = pk2(v0[0], v0[1]); w.y = pk2(v0[2], v0[3]); w.z = pk2(v1[0], v1[1]); w.w = pk2(v1[2], v1[3]);
                        *(u32x4*)(rowp + bj * 128) = w;
                    }
                }
        }
    }
};
struct EpiOut {
    static constexpr bool PERM = false, APERM = false, AFTER_DRAIN = false;
    const float* x; float* out;
    __device__ __forceinline__ void prefetch(const pg8::Unit& u, int tid, float (&pf)[4]) const {
#pragma unroll
        for (int i = 0; i < 4; ++i) { const int line = tid + 512 * i, r = line >> 3, c = (line & 7) * 32; pf[i] = x[(size_t)(u.pm * 256 + r) * DM + u.pn * 256 + c]; }
    }
    __device__ __forceinline__ void prefetch_done(float (&pf)[4]) const { asm volatile("" :: "v"(pf[0]), "v"(pf[1]), "v"(pf[2]), "v"(pf[3])); }
    __device__ __forceinline__ void operator()(const f32x4 (&acc)[2][2][4][2], const pg8::Unit& u, int wr, int wc, int fr, int fq) const {
        const int row0 = u.pm * 256 + wr * 64 + fr, col0 = u.pn * 256 + wc * 32 + 4 * fq;
        const float* xb = x + (size_t)row0 * DM + col0; float* ob = out + (size_t)row0 * DM + col0;
#pragma unroll
        for (int ai = 0; ai < 2; ++ai)
#pragma unroll
            for (int mp = 0; mp < 2; ++mp) {
                f32x4 xv[2][2][2];
#pragma unroll
                for (int mm = 0; mm < 2; ++mm)
#pragma unroll
                    for (int bj = 0; bj < 2; ++bj)
#pragma unroll
                        for (int n = 0; n < 2; ++n) xv[mm][bj][n] = *(const f32x4*)(xb + (size_t)(ai * 128 + (2 * mp + mm) * 16) * DM + bj * 128 + n * 16);
                __builtin_amdgcn_sched_barrier(0);
#pragma unroll
                for (int mm = 0; mm < 2; ++mm)
#pragma unroll
                    for (int bj = 0; bj < 2; ++bj)
#pragma unroll
                        for (int n = 0; n < 2; ++n) *(f32x4*)(ob + (size_t)(ai * 128 + (2 * mp + mm) * 16) * DM + bj * 128 + n * 16) = xv[mm][bj][n] + acc[ai][bj][2 * mp + mm][n];
                __builtin_amdgcn_sched_barrier(0);
            }
    }
};

__device__ __forceinline__ void p0_transpose_item(const float* W, const float* gk, int K, int N, bf16_t* WT, LAS float* scr, int item, int lane) {
    const int nblk = N / 32, kb = item / nblk, nb = item % nblk, k0 = 64 * kb, n0 = 32 * nb;
#pragma unroll 8
    for (int i = 0; i < 32; ++i) { const int kk = 2 * i + (lane >> 5); scr[kk * 33 + (lane & 31)] = W[(size_t)(k0 + kk) * N + n0 + (lane & 31)] * gk[k0 + kk]; }
    LDS_WAIT();
    const int c = lane & 7;
#pragma unroll
    for (int j = 0; j < 4; ++j) {
        const int n = (lane >> 3) + 8 * j; const LAS float* s = scr + (8 * c) * 33 + n;
        u32x4 o; o.x = pk2(s[0 * 33], s[1 * 33]); o.y = pk2(s[2 * 33], s[3 * 33]); o.z = pk2(s[4 * 33], s[5 * 33]); o.w = pk2(s[6 * 33], s[7 * 33]);
        *(u32x4*)(WT + (size_t)(n0 + n) * K + k0 + 8 * c) = o;
    }
    LDS_WAIT();
}

struct Params { const float* in[20]; float* out; unsigned char* ws; };

__device__ __forceinline__ void p0_prologue(const Params& p, LAS unsigned char* lds, int tid, int wave, int lane) {
    LAS float* scr = (LAS float*)(lds + wave * 16384);
    const int gw = blockIdx.x * 8 + wave, NGW = gridDim.x * 8;
    bf16_t* WinT = (bf16_t*)(p.ws + WS_WIN); bf16_t* WoutT = (bf16_t*)(p.ws + WS_WOUT); bf16_t* RF = (bf16_t*)(p.ws + WS_RF);
    float* ROPE = (float*)(p.ws + WS_ROPE); bf16_t* XB = (bf16_t*)(p.ws + WS_XB);
    constexpr int I_IN = (DM / 64) * (NIN / 32);
#pragma unroll 1
    for (int it = gw; it < I_IN; it += NGW) p0_transpose_item(p.in[2], p.in[1], DM, NIN, WinT, scr, it, lane);
    __syncthreads();
    {
        const float* w1 = p.in[5]; const float* b1 = p.in[6]; const float* w2 = p.in[7]; const float* b2 = p.in[8];
        const float* w3 = p.in[9]; const float* b3 = p.in[10]; const float* w4 = p.in[11]; const float* sf = p.in[12];
        const float* hbias = p.in[13];
#pragma unroll 1
        for (int l = gw; l < SEQ; l += NGW) {
            const float t = (float)l / 2047.0f;
            const float w = 6.283185307179586f * (float)l / 2048.0f;
            if (lane < 33) {
                float zi;
                if (lane == 0) zi = t;
                else { const int i = (lane - 1) & 15; const float f = 1e-4f + (float)i * ((15.0f - 1e-4f) / 15.0f); const float a = f * w; zi = (lane <= 16) ? cos_acc(a) : -sin_acc(a); }
                scr[lane] = zi;
            }
            LDS_WAIT();
            const float fr = sf[lane];
            float a = b1[lane];
#pragma unroll 11
            for (int i = 0; i < 33; ++i) a += scr[i] * w1[i * 64 + lane];
            scr[64 + lane] = sin_acc(fr * a);
            LDS_WAIT();
            a = b2[lane];
#pragma unroll 16
            for (int i = 0; i < 64; ++i) a += scr[64 + i] * w2[i * 64 + lane];
            scr[128 + lane] = sin_acc(fr * a);
            LDS_WAIT();
            a = b3[lane];
#pragma unroll 16
            for (int i = 0; i < 64; ++i) a += scr[128 + i] * w3[i * 64 + lane];
            scr[192 + lane] = sin_acc(fr * a);
            LDS_WAIT();
            {
                f32x4 acc4[8];
#pragma unroll
                for (int i = 0; i < 8; ++i) acc4[i] = (f32x4){0.f, 0.f, 0.f, 0.f};
                const f32x4* w4v = (const f32x4*)w4;
                f32x4 stg[8];
#pragma unroll
                for (int q = 0; q < 8; ++q) stg[q] = w4v[tid + 512 * q];
#pragma unroll 1
                for (int jc = 0; jc < 64; jc += 8) {
                    __syncthreads();
#pragma unroll
                    for (int q = 0; q < 8; ++q) { const int idx = tid + 512 * q; *(LAS f32x4*)(lds + (idx >> 9) * 16384 + 8192 + (idx & 511) * 16) = stg[q]; }
                    if (jc + 8 < 64) {
#pragma unroll
                        for (int q = 0; q < 8; ++q) stg[q] = w4v[(jc + 8) * 512 + tid + 512 * q];
                    }
                    __syncthreads();
#pragma unroll
                    for (int jj = 0; jj < 8; ++jj) {
                        const float hj = scr[192 + jc + jj];
                        const LAS f32x4* wr4 = (const LAS f32x4*)(lds + jj * 16384 + 8192) + lane;
#pragma unroll
                        for (int i = 0; i < 8; ++i) acc4[i] += hj * wr4[64 * i];
                    }
                }
#pragma unroll
                for (int i = 0; i < 8; ++i) {
                    float val[4];
#pragma unroll
                    for (int e = 0; e < 4; ++e) {
                        const int n = 4 * lane + 256 * i + e;
                        const int o = n >> 10, dir = (n >> 9) & 1, c = n & 511;
                        const float ad = 3.0701134573f + (float)c * ((15.3505672866f - 3.0701134573f) / 511.0f);
                        val[e] = acc4[i][e] * __expf(-t * ad);
                        if (l == 0 && dir == 0) val[e] += hbias[o * 512 + c];
                    }
                    u32x2 w; w.x = pk2(val[0], val[1]); w.y = pk2(val[2], val[3]);
                    *(u32x2*)(RF + (size_t)l * 2048 + 4 * lane + 256 * i) = w;
                }
            }
            LDS_WAIT();
        }
    }
    for (int idx = blockIdx.x * NTHREADS + tid; idx < SEQ * 32; idx += gridDim.x * NTHREADS) {
        const int pos = idx >> 5, i = idx & 31;
        const float inv = exp2f(-(float)i * (13.287712379549449f / 32.0f));
        const float ang = (float)pos * inv;
        ROPE[idx] = cos_acc(ang); ROPE[SEQ * 32 + idx] = sin_acc(ang);
    }
    {
        const float* x = p.in[0];
#pragma unroll 1
        for (int m = gw; m < NTOK; m += 2 * NGW) {
            const int m2 = m + NGW;
            const bool has2 = m2 < NTOK;
            const f32x4* xr = (const f32x4*)(x + (size_t)m * DM) + lane;
            const f32x4* xr2 = (const f32x4*)(x + (size_t)(has2 ? m2 : m) * DM) + lane;
            f32x4 v[4], v2[4]; float s = 0.f, s2 = 0.f;
#pragma unroll
            for (int j = 0; j < 4; ++j) { v[j] = __builtin_nontemporal_load(xr + 64 * j); v2[j] = __builtin_nontemporal_load(xr2 + 64 * j); }
#pragma unroll
            for (int j = 0; j < 4; ++j) { s += (v[j].x * v[j].x + v[j].y * v[j].y) + (v[j].z * v[j].z + v[j].w * v[j].w); s2 += (v2[j].x * v2[j].x + v2[j].y * v2[j].y) + (v2[j].z * v2[j].z + v2[j].w * v2[j].w); }
            const float rstd = 1.0f / sqrtf(wave_sum(s) * (1.0f / DM) + EPS), rstd2 = 1.0f / sqrtf(wave_sum(s2) * (1.0f / DM) + EPS);
            u32x2* o8 = (u32x2*)(XB + (size_t)m * DM) + lane;
#pragma unroll
            for (int j = 0; j < 4; ++j) { u32x2 w; w.x = pk2(v[j].x * rstd, v[j].y * rstd); w.y = pk2(v[j].z * rstd, v[j].w * rstd); o8[64 * j] = w; }
            if (has2) {
                u32x2* o82 = (u32x2*)(XB + (size_t)m2 * DM) + lane;
#pragma unroll
                for (int j = 0; j < 4; ++j) { u32x2 w; w.x = pk2(v2[j].x * rstd2, v2[j].y * rstd2); w.y = pk2(v2[j].z * rstd2, v2[j].w * rstd2); o82[64 * j] = w; }
            }
        }
    }
}

constexpr int UROWB = 4112;
constexpr int HY_R_OFF = 32 * UROWB;

__device__ __forceinline__ bf16x8 load_afrag(const LAS unsigned* Rw, int n0) {
    const int dw = n0 >> 1; const unsigned sh = (unsigned)(n0 & 1) << 4;
    const unsigned d0 = Rw[dw], d1 = Rw[dw + 1], d2 = Rw[dw + 2], d3 = Rw[dw + 3], d4 = Rw[dw + 4];
    u32x4 f;
    f.x = __builtin_amdgcn_alignbit(d1, d0, sh); f.y = __builtin_amdgcn_alignbit(d2, d1, sh);
    f.z = __builtin_amdgcn_alignbit(d3, d2, sh); f.w = __builtin_amdgcn_alignbit(d4, d3, sh);
    return __builtin_bit_cast(bf16x8, f);
}
__device__ __forceinline__ void hy_conv(f32x16 (&acc)[8], const LAS unsigned char* lds, int wave, int i32, int h) {
    const LAS unsigned* Rw = (const LAS unsigned*)(lds + HY_R_OFF);
    const LAS unsigned char* Ub = lds + i32 * UROWB + 16 * h;
    const int nbase = 2048 - 256 * wave - i32 + 8 * h;
    bf16x8 AE[8], AO[8];
#pragma unroll
    for (int r = 0; r < 8; ++r) {
#pragma unroll
        for (int i = 0; i < 16; ++i) acc[r][i] = 0.f;
        AE[r] = load_afrag(Rw, nbase - 32 * r); AO[r] = load_afrag(Rw, nbase - 32 * r + 16);
    }
    for (int P = 0; P < 8; ++P) {
#pragma unroll
        for (int p = 0; p < 8; ++p) {
            const int S = 8 * P + p;
            const bf16x8 Be = *(const LAS bf16x8*)(Ub + 64 * S), Bo = *(const LAS bf16x8*)(Ub + 64 * S + 32);
#pragma unroll
            for (int r = 0; r < 8; ++r) {
                acc[r] = MFMA32(AE[(r - p) & 7], Be, acc[r]);
                acc[r] = MFMA32(AO[(r - p) & 7], Bo, acc[r]);
            }
            if (S + 1 < 64) { AE[(7 - p) & 7] = load_afrag(Rw, nbase + 32 * (S + 1)); AO[(7 - p) & 7] = load_afrag(Rw, nbase + 32 * (S + 1) + 16); }
        }
    }
}

__device__ __forceinline__ void hy_stage(LAS unsigned char* lds, const bf16_t* hy, float w0, float w1, float w2, float bias, int tid) {
#pragma unroll 4
    for (int ch = tid; ch < 8192; ch += NTHREADS) {
        const int b = ch >> 8, t0 = (ch & 255) << 3; const bf16_t* row = hy + b * SEQ;
        const u32x4 v = *(const u32x4*)(row + t0);
        float x[10];
        x[0] = bf1(row[(t0 > 0) ? t0 - 1 : 0]); x[9] = bf1(row[(t0 + 8 < SEQ) ? t0 + 8 : SEQ - 1]);
        x[0] = (t0 > 0) ? x[0] : 0.f; x[9] = (t0 + 8 < SEQ) ? x[9] : 0.f;
        x[1] = bf_lo(v.x); x[2] = bf_hi(v.x); x[3] = bf_lo(v.y); x[4] = bf_hi(v.y); x[5] = bf_lo(v.z); x[6] = bf_hi(v.z); x[7] = bf_lo(v.w); x[8] = bf_hi(v.w);
        float o[8];
#pragma unroll
        for (int j = 0; j < 8; ++j) o[j] = bias + w0 * x[j] + w1 * x[j + 1] + w2 * x[j + 2];
        u32x4 w; w.x = pk2(o[0], o[1]); w.y = pk2(o[2], o[3]); w.z = pk2(o[4], o[5]); w.w = pk2(o[6], o[7]);
        *(LAS u32x4*)(lds + b * UROWB + t0 * 2) = w;
    }
}
__device__ __forceinline__ void hy_gate_inplace(LAS unsigned char* lds, const f32x16 (&acc)[8], int wave, int i32, int h) {
    LAS unsigned char* lp = lds + i32 * UROWB + (256 * wave + 4 * h) * 2;
#pragma unroll
    for (int r = 0; r < 8; ++r)
#pragma unroll
        for (int g = 0; g < 4; ++g) {
            LAS u32x2* up = (LAS u32x2*)(lp + (32 * r + 8 * g) * 2);
            const u32x2 uu = *up;
            u32x2 w; w.x = pk2(bf_lo(uu.x) * acc[r][4 * g + 0], bf_hi(uu.x) * acc[r][4 * g + 1]); w.y = pk2(bf_lo(uu.y) * acc[r][4 * g + 2], bf_hi(uu.y) * acc[r][4 * g + 3]);
            *up = w;
        }
}
__device__ __forceinline__ void hy_load_filter(LAS unsigned char* lds, const bf16_t* RF, int o, int c, int tid) {
    unsigned v[8];
#pragma unroll
    for (int j = 0; j < 8; ++j) {
        const int n = 8 * tid + j;
        const int dir = (n > 2048) ? 1 : 0, l = (n > 2048) ? n - 2048 : 2048 - n;
        const int ll = (l > 2047) ? 2047 : l;
        v[j] = RF[(size_t)ll * 2048 + (o * 2 + dir) * 512 + c];
        if (n == 0) v[j] = 0u;
    }
    u32x4 w; w.x = v[0] | (v[1] << 16); w.y = v[2] | (v[3] << 16); w.z = v[4] | (v[5] << 16); w.w = v[6] | (v[7] << 16);
    *(LAS u32x4*)(lds + HY_R_OFF + tid * 16) = w;
}
__device__ __forceinline__ void hyena_unit(const Params& p, LAS unsigned char* lds, int c, int tid, int wave, int lane) {
    const bf16_t* HYT = (const bf16_t*)(p.ws + WS_HYT); const bf16_t* RF = (const bf16_t*)(p.ws + WS_RF); bf16_t* ZT = (bf16_t*)(p.ws + WS_ZT);
    const float* cw = p.in[3]; const float* cb = p.in[4];
    asm volatile("" : "+v"(tid), "+v"(lane));
    int i32 = lane & 31, h = lane >> 5;
    hy_stage(lds, HYT + (size_t)c * NTOK, cw[c], cw[1536 + c], cw[3072 + c], cb[c], tid);
    hy_load_filter(lds, RF, 0, c, tid);
    if (tid < 4) *(LAS unsigned*)(lds + HY_R_OFF + 8192 + tid * 4) = 0u;
    __syncthreads();
    f32x16 acc[8];
    hy_conv(acc, lds, wave, i32, h);
    __syncthreads();
    asm volatile("" : "+v"(tid), "+v"(i32), "+v"(h));
    hy_stage(lds, HYT + (size_t)(512 + c) * NTOK, cw[512 + c], cw[1536 + 512 + c], cw[3072 + 512 + c], cb[512 + c], tid);
    hy_load_filter(lds, RF, 1, c, tid);
    __syncthreads();
    hy_gate_inplace(lds, acc, wave, i32, h);
    __syncthreads();
    hy_conv(acc, lds, wave, i32, h);
    __syncthreads();
    asm volatile("" : "+v"(tid), "+v"(i32), "+v"(h));
    hy_stage(lds, HYT + (size_t)(1024 + c) * NTOK, cw[1024 + c], cw[1536 + 1024 + c], cw[3072 + 1024 + c], cb[1024 + c], tid);
    __syncthreads();
    hy_gate_inplace(lds, acc, wave, i32, h);
    __syncthreads();
    {
        bf16_t* zt = ZT + (size_t)c * NTOK;
#pragma unroll 4
        for (int ch = tid; ch < 8192; ch += NTHREADS) {
            const int b = ch >> 8, t0 = (ch & 255) << 3;
            *(u32x4*)(zt + b * SEQ + t0) = *(const LAS u32x4*)(lds + b * UROWB + t0 * 2);
        }
    }
    __syncthreads();
}

constexpr int KROWB = 144;
constexpr int VROWB = 792;
constexpr int AT_V_OFF = 384 * KROWB;

__device__ __forceinline__ void attn_unit(const Params& p, LAS unsigned char* lds, int unit, int tid, int wave, int lane) {
    const bf16_t* proj = (const bf16_t*)(p.ws + WS_PROJ); const float* ROPE = (const float*)(p.ws + WS_ROPE); bf16_t* YA = (bf16_t*)(p.ws + WS_YA);
    const float* qg = p.in[14]; const float* kg = p.in[15]; const float* sink = p.in[16];
    const int b = unit >> 4, start = (unit & 15) * 128;
    asm volatile("" : "+v"(tid), "+v"(lane));
    const int i32 = lane & 31, h = lane >> 5;
    const float* RC = ROPE; const float* RS = ROPE + SEQ * 32;
    for (int kvh = 0; kvh < 2; ++kvh) {
#pragma unroll
        for (int task = tid; task < 1536; task += NTHREADS) {
            const int kk = task >> 2, c4 = task & 3, kp = start - 128 + kk;
            const bool valid = (kp >= 0) && (kp < SEQ);
            float x1[8], x2[8]; float ss = 0.f;
            if (valid) {
                const bf16_t* src = proj + (size_t)(b * SEQ + kp) * NPROJ + PJ_K + kvh * 64 + 8 * c4;
                const u32x4 a = *(const u32x4*)src, bq = *(const u32x4*)(src + 32);
                x1[0] = bf_lo(a.x); x1[1] = bf_hi(a.x); x1[2] = bf_lo(a.y); x1[3] = bf_hi(a.y); x1[4] = bf_lo(a.z); x1[5] = bf_hi(a.z); x1[6] = bf_lo(a.w); x1[7] = bf_hi(a.w);
                x2[0] = bf_lo(bq.x); x2[1] = bf_hi(bq.x); x2[2] = bf_lo(bq.y); x2[3] = bf_hi(bq.y); x2[4] = bf_lo(bq.z); x2[5] = bf_hi(bq.z); x2[6] = bf_lo(bq.w); x2[7] = bf_hi(bq.w);
#pragma unroll
                for (int j = 0; j < 8; ++j) ss += x1[j] * x1[j] + x2[j] * x2[j];
            } else {
#pragma unroll
                for (int j = 0; j < 8; ++j) { x1[j] = 0.f; x2[j] = 0.f; }
            }
            ss += __shfl_xor(ss, 1); ss += __shfl_xor(ss, 2);
            u32x4 o1 = {0u, 0u, 0u, 0u}, o2 = {0u, 0u, 0u, 0u};
            if (valid) {
                const float rstd = 1.0f / sqrtf(ss * (1.0f / 64.0f) + EPS);
                const f32x4 c0 = *(const f32x4*)(RC + kp * 32 + 8 * c4), c1 = *(const f32x4*)(RC + kp * 32 + 8 * c4 + 4);
                const f32x4 s0 = *(const f32x4*)(RS + kp * 32 + 8 * c4), s1 = *(const f32x4*)(RS + kp * 32 + 8 * c4 + 4);
                float r1[8], r2[8];
#pragma unroll
                for (int j = 0; j < 8; ++j) {
                    const float cc = (j < 4) ? c0[j & 3] : c1[j & 3], sn = (j < 4) ? s0[j & 3] : s1[j & 3];
                    const float a1 = x1[j] * rstd * kg[8 * c4 + j], a2 = x2[j] * rstd * kg[32 + 8 * c4 + j];
                    r1[j] = a1 * cc - a2 * sn; r2[j] = a2 * cc + a1 * sn;
                }
                o1.x = pk2(r1[0], r1[1]); o1.y = pk2(r1[2], r1[3]); o1.z = pk2(r1[4], r1[5]); o1.w = pk2(r1[6], r1[7]);
                o2.x = pk2(r2[0], r2[1]); o2.y = pk2(r2[2], r2[3]); o2.z = pk2(r2[4], r2[5]); o2.w = pk2(r2[6], r2[7]);
            }
            *(LAS u32x4*)(lds + kk * KROWB + 16 * c4) = o1;
            *(LAS u32x4*)(lds + kk * KROWB + 64 + 16 * c4) = o2;
        }
#pragma unroll
        for (int it = 0; it < 2; ++it) {
            const int task = tid + it * NTHREADS;
            if (task < 768) {
                const int kg = task >> 3, c8 = task & 7, kk = 4 * kg, kp = start - 128 + kk;
                u32x4 a0 = {0u, 0u, 0u, 0u}, a1 = a0, a2 = a0, a3 = a0;
                if (kp >= 0 && kp < SEQ) {
                    const bf16_t* src = proj + (size_t)(b * SEQ + kp) * NPROJ + PJ_V + kvh * 64 + 8 * c8;
                    a0 = *(const u32x4*)src; a1 = *(const u32x4*)(src + NPROJ); a2 = *(const u32x4*)(src + 2 * NPROJ); a3 = *(const u32x4*)(src + 3 * NPROJ);
                }
                LAS unsigned char* dst = lds + AT_V_OFF + (8 * c8) * VROWB + kk * 2;
#pragma unroll
                for (int w = 0; w < 4; ++w) {
                    u32x2 lo, hi;
                    lo.x = __builtin_amdgcn_perm(a1[w], a0[w], 0x05040100u); lo.y = __builtin_amdgcn_perm(a3[w], a2[w], 0x05040100u);
                    hi.x = __builtin_amdgcn_perm(a1[w], a0[w], 0x07060302u); hi.y = __builtin_amdgcn_perm(a3[w], a2[w], 0x07060302u);
                    *(LAS u32x2*)(dst + (2 * w) * VROWB) = lo;
                    *(LAS u32x2*)(dst + (2 * w + 1) * VROWB) = hi;
                }
            }
        }
        const int g = wave >> 1, half = wave & 1, hq = kvh * 4 + g, p0 = start + 64 * half;
        u32x4 qraw[2][4];
#pragma unroll
        for (int qt = 0; qt < 2; ++qt) {
            const bf16_t* src = proj + (size_t)(b * SEQ + p0 + 32 * qt + i32) * NPROJ + PJ_Q + hq * 64 + 8 * h;
#pragma unroll
            for (int ks = 0; ks < 4; ++ks) qraw[qt][ks] = *(const u32x4*)(src + 16 * ks);
        }
        __syncthreads();
        bf16x8 qf[2][4];
#pragma unroll
        for (int qt = 0; qt < 2; ++qt) {
            const int pos = p0 + 32 * qt + i32;
            float x[4][8]; float ss = 0.f;
#pragma unroll
            for (int ks = 0; ks < 4; ++ks) {
                const u32x4 a = qraw[qt][ks];
                x[ks][0] = bf_lo(a.x); x[ks][1] = bf_hi(a.x); x[ks][2] = bf_lo(a.y); x[ks][3] = bf_hi(a.y); x[ks][4] = bf_lo(a.z); x[ks][5] = bf_hi(a.z); x[ks][6] = bf_lo(a.w); x[ks][7] = bf_hi(a.w);
#pragma unroll
                for (int j = 0; j < 8; ++j) ss += x[ks][j] * x[ks][j];
            }
            ss += __shfl_xor(ss, 32);
            const float rstd = (0.125f * 1.4426950408889634f) / sqrtf(ss * (1.0f / 64.0f) + EPS);
#pragma unroll
            for (int ks = 0; ks < 2; ++ks) {
                const int d1 = 16 * ks + 8 * h;
                const f32x4 c0 = *(const f32x4*)(RC + pos * 32 + d1), c1 = *(const f32x4*)(RC + pos * 32 + d1 + 4);
                const f32x4 s0 = *(const f32x4*)(RS + pos * 32 + d1), s1 = *(const f32x4*)(RS + pos * 32 + d1 + 4);
#pragma unroll
                for (int j = 0; j < 8; ++j) {
                    const float cc = (j < 4) ? c0[j & 3] : c1[j & 3], sn = (j < 4) ? s0[j & 3] : s1[j & 3];
                    const float a1 = x[ks][j] * rstd * qg[d1 + j], a2 = x[ks + 2][j] * rstd * qg[d1 + 32 + j];
                    x[ks][j] = a1 * cc - a2 * sn; x[ks + 2][j] = a2 * cc + a1 * sn;
                }
            }
#pragma unroll
            for (int ks = 0; ks < 4; ++ks) {
                u32x4 w; w.x = pk2(x[ks][0], x[ks][1]); w.y = pk2(x[ks][2], x[ks][3]); w.z = pk2(x[ks][4], x[ks][5]); w.w = pk2(x[ks][6], x[ks][7]);
                qf[qt][ks] = __builtin_bit_cast(bf16x8, w);
            }
        }
        const float sink2 = sink[hq] * 1.4426950408889634f;
        float mrun[2] = {sink2, sink2}, lrun[2] = {1.0f, 1.0f};
        f32x16 o[2][2];
#pragma unroll
        for (int a = 0; a < 2; ++a)
#pragma unroll
            for (int c = 0; c < 2; ++c)
#pragma unroll
                for (int i = 0; i < 16; ++i) o[a][c][i] = 0.f;
        for (int jt = 0; jt < 5; ++jt) {
            const int kk0 = 64 * half + 64 * jt, kp0 = start - 128 + kk0;
            if (kp0 + 63 < 0 || kp0 >= SEQ) continue;
            const bool need_mask = (jt == 0) || (jt == 4) || (kp0 < 0) || (kp0 + 64 > SEQ);
            f32x16 st[2][2];
#pragma unroll
            for (int a = 0; a < 2; ++a)
#pragma unroll
                for (int c = 0; c < 2; ++c)
#pragma unroll
                    for (int i = 0; i < 16; ++i) st[a][c][i] = 0.f;
#pragma unroll
            for (int ks = 0; ks < 4; ++ks) {
                const bf16x8 kf0 = *(const LAS bf16x8*)(lds + (kk0 + i32) * KROWB + (16 * ks + 8 * h) * 2);
                const bf16x8 kf1 = *(const LAS bf16x8*)(lds + (kk0 + 32 + i32) * KROWB + (16 * ks + 8 * h) * 2);
#pragma unroll
                for (int qt = 0; qt < 2; ++qt) { st[0][qt] = MFMA32(kf0, qf[qt][ks], st[0][qt]); st[1][qt] = MFMA32(kf1, qf[qt][ks], st[1][qt]); }
            }
#pragma unroll
            for (int qt = 0; qt < 2; ++qt) {
                const int qpos = p0 + 32 * qt + i32;
                float mx = -INFINITY;
#pragma unroll
                for (int mt = 0; mt < 2; ++mt)
#pragma unroll
                    for (int i = 0; i < 16; ++i) {
                        float s = st[mt][qt][i];
                        if (need_mask) {
                            const int kp = kp0 + 32 * mt + (i & 3) + 8 * (i >> 2) + 4 * h;
                            const int dlt = kp - qpos;
                            const bool ok = (kp >= 0) && (kp < SEQ) && (dlt <= 128) && (dlt >= -128);
                            s = ok ? s : -INFINITY;
                            st[mt][qt][i] = s;
                        }
                        mx = fmaxf(mx, s);
                    }
                mx = fmaxf(mx, __shfl_xor(mx, 32));
                const float mnew = fmaxf(mrun[qt], mx);
                const float alpha = __builtin_amdgcn_exp2f(mrun[qt] - mnew);
                mrun[qt] = mnew;
                float rs = 0.f;
#pragma unroll
                for (int mt = 0; mt < 2; ++mt)
#pragma unroll
                    for (int i = 0; i < 16; ++i) { const float pv = __builtin_amdgcn_exp2f(st[mt][qt][i] - mnew); st[mt][qt][i] = pv; rs += pv; }
                rs += __shfl_xor(rs, 32);
                lrun[qt] = lrun[qt] * alpha + rs;
#pragma unroll
                for (int i = 0; i < 16; ++i) { o[0][qt][i] *= alpha; o[1][qt][i] *= alpha; }
            }
#pragma unroll
            for (int mt = 0; mt < 2; ++mt)
#pragma unroll
                for (int s2 = 0; s2 < 2; ++s2) {
                    bf16x8 pf[2];
#pragma unroll
                    for (int qt = 0; qt < 2; ++qt) {
                        u32x4 w; w.x = pk2(st[mt][qt][8 * s2 + 0], st[mt][qt][8 * s2 + 1]); w.y = pk2(st[mt][qt][8 * s2 + 2], st[mt][qt][8 * s2 + 3]);
                        w.z = pk2(st[mt][qt][8 * s2 + 4], st[mt][qt][8 * s2 + 5]); w.w = pk2(st[mt][qt][8 * s2 + 6], st[mt][qt][8 * s2 + 7]);
                        pf[qt] = __builtin_bit_cast(bf16x8, w);
                    }
                    const int kb = kk0 + 32 * mt + 16 * s2 + 4 * h;
#pragma unroll
                    for (int dt = 0; dt < 2; ++dt) {
                        const LAS unsigned char* vp = lds + AT_V_OFF + (32 * dt + i32) * VROWB + kb * 2;
                        const u32x2 lo = *(const LAS u32x2*)vp, hi = *(const LAS u32x2*)(vp + 16);
                        u32x4 w; w.x = lo.x; w.y = lo.y; w.z = hi.x; w.w = hi.y;
                        const bf16x8 vf = __builtin_bit_cast(bf16x8, w);
#pragma unroll
                        for (int qt = 0; qt < 2; ++qt) o[dt][qt] = MFMA32(vf, pf[qt], o[dt][qt]);
                    }
                }
        }
#pragma unroll
        for (int qt = 0; qt < 2; ++qt) {
            const float inv = 1.0f / lrun[qt];
            bf16_t* dst = YA + (size_t)(b * SEQ + p0 + 32 * qt + i32) * DH + hq * 64 + 4 * h;
#pragma unroll
            for (int dt = 0; dt < 2; ++dt)
#pragma unroll
                for (int g4 = 0; g4 < 4; ++g4) {
                    u32x2 w; w.x = pk2(o[dt][qt][4 * g4 + 0] * inv, o[dt][qt][4 * g4 + 1] * inv); w.y = pk2(o[dt][qt][4 * g4 + 2] * inv, o[dt][qt][4 * g4 + 3] * inv);
                    *(u32x2*)(dst + 32 * dt + 8 * g4) = w;
                }
        }
        __syncthreads();
    }
}

constexpr int TROWB = 1028;
__device__ __forceinline__ void p3_unit(const Params& p, LAS unsigned char* lds, int unit, int tid, int wave, int lane) {
    const bf16_t* ZT = (const bf16_t*)(p.ws + WS_ZT); const bf16_t* YA = (const bf16_t*)(p.ws + WS_YA); const bf16_t* proj = (const bf16_t*)(p.ws + WS_PROJ);
    bf16_t* Y = (bf16_t*)(p.ws + WS_Y);
    const int tok0 = unit * 64;
#pragma unroll 4
    for (int task = tid; task < 2048; task += NTHREADS) {
        const int cp = task >> 3, ch = task & 7;
        const u32x4 v0 = *(const u32x4*)(ZT + (size_t)(2 * cp) * NTOK + tok0 + 8 * ch), v1 = *(const u32x4*)(ZT + (size_t)(2 * cp + 1) * NTOK + tok0 + 8 * ch);
        LAS unsigned char* dst = lds + (8 * ch) * TROWB + 4 * cp;
#pragma unroll
        for (int w = 0; w < 4; ++w) {
            *(LAS unsigned*)(dst + (2 * w) * TROWB) = __builtin_amdgcn_perm(v1[w], v0[w], 0x05040100u);
            *(LAS unsigned*)(dst + (2 * w + 1) * TROWB) = __builtin_amdgcn_perm(v1[w], v0[w], 0x07060302u);
        }
    }
    __syncthreads();
    for (int half = 0; half < 2; ++half) {
        unsigned zh[4][4], gh4[4][4], za[4][4], ga4[4][4];
#pragma unroll
        for (int q = 0; q < 4; ++q) {
            const int tt = wave + 8 * (4 * half + q); const size_t token = (size_t)(tok0 + tt);
            const LAS unsigned* rw = (const LAS unsigned*)(lds + tt * TROWB);
            const unsigned* gh = (const unsigned*)(proj + token * NPROJ + PJ_GH); const unsigned* ga = (const unsigned*)(proj + token * NPROJ + PJ_GA);
            const unsigned* ya = (const unsigned*)(YA + token * DH);
#pragma unroll
            for (int k = 0; k < 4; ++k) { zh[q][k] = rw[lane + 64 * k]; gh4[q][k] = gh[lane + 64 * k]; za[q][k] = ya[lane + 64 * k]; ga4[q][k] = ga[lane + 64 * k]; }
        }
#pragma unroll
        for (int q = 0; q < 4; ++q) {
            const int tt = wave + 8 * (4 * half + q); const size_t token = (size_t)(tok0 + tt);
            float ssh = 0.f, ssa = 0.f;
#pragma unroll
            for (int k = 0; k < 4; ++k) { const float a = bf_lo(zh[q][k]), bq = bf_hi(zh[q][k]), c2 = bf_lo(za[q][k]), d2 = bf_hi(za[q][k]); ssh += a * a + bq * bq; ssa += c2 * c2 + d2 * d2; }
            const float rh = 1.0f / sqrtf(wave_sum(ssh) * (1.0f / 512.0f) + EPS), ra = 1.0f / sqrtf(wave_sum(ssa) * (1.0f / 512.0f) + EPS);
            unsigned* yo = (unsigned*)(Y + token * DM);
#pragma unroll
            for (int k = 0; k < 4; ++k) {
                yo[lane + 64 * k] = pk2(bf_lo(zh[q][k]) * rh * silu_f(bf_lo(gh4[q][k])), bf_hi(zh[q][k]) * rh * silu_f(bf_hi(gh4[q][k])));
                yo[256 + lane + 64 * k] = pk2(bf_lo(za[q][k]) * ra * silu_f(bf_lo(ga4[q][k])), bf_hi(za[q][k]) * ra * silu_f(bf_hi(ga4[q][k])));
            }
        }
    }
    __syncthreads();
}

__device__ __forceinline__ void grid_bar(unsigned* ctr, unsigned target) {
    asm volatile("s_waitcnt vmcnt(0) lgkmcnt(0)" ::: "memory");
    __syncthreads();
    if (threadIdx.x == 0) {
        __builtin_amdgcn_fence(__ATOMIC_RELEASE, "agent");
        asm volatile("s_waitcnt vmcnt(0)" ::: "memory");
        __hip_atomic_fetch_add(ctr, 1u, __ATOMIC_RELAXED, __HIP_MEMORY_SCOPE_AGENT);
        while (__hip_atomic_load(ctr, __ATOMIC_RELAXED, __HIP_MEMORY_SCOPE_AGENT) < target) __builtin_amdgcn_s_sleep(1);
        __builtin_amdgcn_fence(__ATOMIC_ACQUIRE, "agent");
        asm volatile("s_waitcnt vmcnt(0)" ::: "memory");
    }
    __syncthreads();
}

__global__ void __launch_bounds__(NTHREADS) hymba_fwd(Params p) {
    extern __shared__ __attribute__((aligned(16))) unsigned char lds_raw[];
    LAS unsigned char* lds = (LAS unsigned char*)lds_raw;
    cg::grid_group grid = cg::this_grid();
    unsigned* ctl = (unsigned*)(p.ws + WS_CTL);
    int tid = threadIdx.x, lane = tid & 63, wave = __builtin_amdgcn_readfirstlane(tid >> 6);
#define FRESH_IDS() do { tid = threadIdx.x; asm volatile("" : "+v"(tid)); lane = tid & 63; wave = __builtin_amdgcn_readfirstlane(tid >> 6); } while (0)

    if (blockIdx.x == 0 && tid < 3) __hip_atomic_store(ctl + 64 * tid, 0u, __ATOMIC_RELAXED, __HIP_MEMORY_SCOPE_AGENT);
    p0_prologue(p, lds, tid, wave, lane);
    grid.sync();
    FRESH_IDS();
    {
        pg8::Gemm g{(const bf16_t*)(p.ws + WS_XB), (const bf16_t*)(p.ws + WS_WIN), NTOK, NIN, DM};
        pg8::StaticOrder S; S.init(NTOK, NIN, (int)gridDim.x, (int)blockIdx.x);
        EpiIn E{(bf16_t*)(p.ws + WS_HYT), (bf16_t*)(p.ws + WS_PROJ)};
        pg8::gemm_phase2<EpiIn, pg8::StaticOrder, GEMM_ALIGN, GEMM_SP2>(lds, g, S, E);
    }
    grid_bar(ctl + 0, gridDim.x);
    FRESH_IDS();
    {
        const int vcu = ((gridDim.x & 7) == 0) ? (int)((blockIdx.x & 7) * (gridDim.x >> 3) + (blockIdx.x >> 3)) : (int)blockIdx.x;
        for (int u = vcu; u < NB * 16; u += gridDim.x) attn_unit(p, lds, u, tid, wave, lane);
    }
    FRESH_IDS();
    {
        const int vcu = ((gridDim.x & 7) == 0) ? (int)((blockIdx.x & 7) * (gridDim.x >> 3) + (blockIdx.x >> 3)) : (int)blockIdx.x;
        for (int u = vcu; u < DH; u += gridDim.x) hyena_unit(p, lds, u, tid, wave, lane);
    }
    grid_bar(ctl + 64, gridDim.x);
    FRESH_IDS();
    {
        LAS float* scr = (LAS float*)(lds + wave * 16384);
        bf16_t* WoutT = (bf16_t*)(p.ws + WS_WOUT);
#pragma unroll 1
        for (int it = blockIdx.x * 8 + wave; it < (DM / 64) * (DM / 32); it += gridDim.x * 8) {
            const int kb = it / (DM / 32);
            p0_transpose_item(p.in[19], (kb < 8) ? p.in[17] : (p.in[18] - 512), DM, DM, WoutT, scr, it, lane);
        }
        __syncthreads();
    }
    for (int u = blockIdx.x; u < NTOK / 64; u += gridDim.x) p3_unit(p, lds, u, tid, wave, lane);
    grid_bar(ctl + 128, gridDim.x);
    FRESH_IDS();
    {
        pg8::Gemm g{(const bf16_t*)(p.ws + WS_Y), (const bf16_t*)(p.ws + WS_WOUT), NTOK, DM, DM};
        pg8::StaticOrder S; S.init(NTOK, DM, (int)gridDim.x, (int)blockIdx.x);
        EpiOut E{p.in[0], p.out};
        pg8::gemm_phase2<EpiOut, pg8::StaticOrder, GEMM_ALIGN, GEMM_SP2>(lds, g, S, E);
    }
}

extern "C" void kernel_launch(void* const* d_in, const int* in_sizes, int n_in, void* d_out, int out_size, void* d_ws, size_t ws_size, hipStream_t stream) {
    static int grid = 0;
    if (grid == 0) {
        if (n_in != 20 || ws_size < WS_END) { fprintf(stderr, "kernel_launch: unexpected inputs (n_in %d, ws %zu < %zu)\n", n_in, ws_size, (size_t)WS_END); grid = -1; return; }
        int dev = 0, cus = 0, per_cu = 0;
        hipGetDevice(&dev);
        hipDeviceGetAttribute(&cus, hipDeviceAttributeMultiprocessorCount, dev);
        if (hipFuncSetAttribute((const void*)hymba_fwd, hipFuncAttributeMaxDynamicSharedMemorySize, LDS_BYTES) != hipSuccess) fprintf(stderr, "kernel_launch: hipFuncSetAttribute failed\n");
        if (hipOccupancyMaxActiveBlocksPerMultiprocessor(&per_cu, (const void*)hymba_fwd, NTHREADS, LDS_BYTES) != hipSuccess || per_cu < 1) { fprintf(stderr, "kernel_launch: occupancy query gave %d\n", per_cu); per_cu = 1; }
        (void)hipGetLastError();
        grid = cus * (per_cu > 1 ? 1 : per_cu);
        if (grid > 256) grid = 256;
    }
    if (grid < 0) return;
    Params p{};
    for (int i = 0; i < 20; ++i) p.in[i] = (const float*)d_in[i];
    p.out = (float*)d_out; p.ws = (unsigned char*)d_ws;
    void* args[] = {&p};
    hipError_t e = hipLaunchCooperativeKernel((const void*)hymba_fwd, dim3(grid), dim3(NTHREADS), args, LDS_BYTES, stream);
    if (e != hipSuccess) fprintf(stderr, "cooperative launch failed: %s (grid %d)\n", hipGetErrorString(e), grid);
}
```

```cpp
#include <hip/hip_runtime.h>
#include <hip/hip_cooperative_groups.h>
#include <cstdio>
namespace cg = cooperative_groups;
namespace pg8 {
#define PG8_LAS __attribute__((address_space(3)))
typedef unsigned short bf16_t;
typedef short bf16x8 __attribute__((ext_vector_type(8)));
typedef float f32x4 __attribute__((ext_vector_type(4)));
typedef unsigned u32x4 __attribute__((ext_vector_type(4)));
constexpr int BM = 256, BK = 64, HALF = 128, HTB = HALF * BK * 2  , STAGE_BYTES = 8 * HTB, NXCD = 8, WGM = 4;

__host__ __device__ __forceinline__ int lds_byte(int r, int c) { const int st = (r >> 4) * 2 + (c >> 5), rr = r & 15, cc = c & 31, ob = rr * 64 + cc * 2; return st * 1024 + (ob ^ (((ob >> 9) & 1) << 5)); }
__host__ __device__ __forceinline__ void stage_rc(int b, int& R, int& C) { const int st = b / 1024, sb = b % 1024, swz = sb ^ (((sb >> 9) & 1) << 5); R = (st >> 1) * 16 + swz / 64; C = (st & 1) * 32 + (swz % 64) / 2; }
__host__ __device__ __forceinline__ int perm32(int rho) { const int n = rho >> 4, i = rho & 15; return 8 * (i >> 2) + 4 * n + (i & 3); }

struct Unit { int pm, pn; };
struct Gemm { const bf16_t* A; const bf16_t* Bt; int M, N, K; };

struct StaticOrder {
    int nM, nN, nwg, G, c;
    __host__ __device__ void init(int M, int N, int G_, int c_) { nM = M / BM; nN = N / BM; nwg = nM * nN; G = G_; c = c_; }
    __host__ __device__ bool next(int i, Unit& u) const {
        const long L = (long)i * G + c; if (L >= nwg) return false;
        int wgid = (int)L; { const int q = nwg / NXCD, r = nwg % NXCD, xcd = wgid % NXCD, off = wgid / NXCD; wgid = (xcd < r ? xcd * (q + 1) : r * (q + 1) + (xcd - r) * q) + off; }
        const int nig = WGM * nN, gid = wgid / nig, fm = gid * WGM, gsz = (nM - fm) < WGM ? (nM - fm) : WGM;
        u.pm = fm + ((wgid % nig) % gsz); u.pn = (wgid % nig) / gsz; return true;
    }
    __device__ __forceinline__ void a_ready(const Unit&) const {}
    __device__ __forceinline__ void done(const Unit&) const {}
};

template <class Epi, class Sched, bool ALIGN_EPI = false, bool SP2 = false>
__device__ __forceinline__ void gemm_phase2(PG8_LAS unsigned char* lds, const Gemm g, const Sched& S, const Epi& E) {
    int tid_raw = threadIdx.x; asm volatile("" : "+v"(tid_raw));
    const int tid = tid_raw, wid = __builtin_amdgcn_readfirstlane(tid >> 6), lane = tid & 63, wr = wid >> 2, wc = wid & 3, fr = lane & 15, fq = lane >> 4;
    const int K = g.K, nt = K / BK;
    unsigned voffA[2], voffB[2];
#pragma unroll
    for (int i = 0; i < 2; ++i) { int R, C; stage_rc(tid * 16 + i * 8192, R, C); const int Rb = Epi::PERM ? ((R & ~31) + perm32(R & 31)) : R;
        const int Ra = Epi::APERM ? (128 * (R >> 6) + 8 * (R & 15) + ((R >> 4) & 3)) : R; voffA[i] = (unsigned)(Ra * K + C) * 2u; voffB[i] = (unsigned)(Rb * K + C) * 2u; }
    const size_t kstep = (size_t)(BK * 2);
    const size_t hstep = (size_t)HALF * K * 2;
    const size_t tstep = 2 * hstep;
    const size_t hstepA = Epi::APERM ? (size_t)4 * K * 2 : hstep;
    const unsigned ldsw = (unsigned)wid * 1024u;
    const int aoff = lds_byte(wr * 64 + fr, fq * 8), boff = lds_byte(wc * 32 + fr, fq * 8);
#define PG8_SA(b, h) (((b) * 2 + (h)) * HTB)
#define PG8_SB(b, h) ((4 + (b) * 2 + (h)) * HTB)
#define PG8_STAGE(bufoff, gbase, voff) do { _Pragma("unroll") for (int _i = 0; _i < 2; ++_i) \
        __builtin_amdgcn_global_load_lds((const unsigned*)((const char*)(gbase) + (voff)[_i]), (PG8_LAS unsigned*)(lds + (bufoff) + ldsw + _i * 8192), 16, 0, 0); } while (0)
#define PG8_LDA(dst, b, h) do { _Pragma("unroll") for (int m = 0; m < 4; ++m) _Pragma("unroll") for (int k = 0; k < 2; ++k) dst[m][k] = *(const PG8_LAS bf16x8*)(lds + PG8_SA(b, h) + aoff + m * 2048 + k * 1024); } while (0)
#define PG8_LDB(dst, b, h) do { _Pragma("unroll") for (int n = 0; n < 2; ++n) _Pragma("unroll") for (int k = 0; k < 2; ++k) dst[n][k] = *(const PG8_LAS bf16x8*)(lds + PG8_SB(b, h) + boff + n * 2048 + k * 1024); } while (0)
#define PG8_MMA(ai, bj, At, Bt) do { __builtin_amdgcn_s_setprio(1); _Pragma("unroll") for (int m = 0; m < 4; ++m) _Pragma("unroll") for (int n = 0; n < 2; ++n) _Pragma("unroll") for (int k = 0; k < 2; ++k) \
        acc[ai][bj][m][n] = __builtin_amdgcn_mfma_f32_16x16x32_bf16(Bt[n][k], At[m][k], acc[ai][bj][m][n], 0, 0, 0); __builtin_amdgcn_s_setprio(0); } while (0)
#define PG8_WAIT_V(n) asm volatile("s_waitcnt vmcnt(" #n ")" ::: "memory")
#define PG8_WAIT_L(n) asm volatile("s_waitcnt lgkmcnt(" #n ")" ::: "memory")
#define PG8_BAR __builtin_amdgcn_s_barrier()
#define PG8_SCHED __builtin_amdgcn_sched_barrier(0)
    Unit cur, nxt; int ui = 0;
    if (!S.next(0, cur)) return;
    f32x4 acc[2][2][4][2];
#pragma unroll
    for (int a = 0; a < 2; ++a)
#pragma unroll
        for (int b = 0; b < 2; ++b)
#pragma unroll
            for (int m = 0; m < 4; ++m)
#pragma unroll
                for (int n = 0; n < 2; ++n) acc[a][b][m][n] = (f32x4){0.f, 0.f, 0.f, 0.f};
    bf16x8 At[4][2], B0[2][2], B1[2][2];
    const char* cA = (const char*)g.A + (size_t)cur.pm * tstep; const char* cB = (const char*)g.Bt + (size_t)cur.pn * tstep;
    S.a_ready(cur);
    if constexpr (SP2) {
        PG8_STAGE(PG8_SB(0, 0), cB, voffB); PG8_STAGE(PG8_SB(0, 1), cB + hstep, voffB); PG8_STAGE(PG8_SA(0, 0), cA, voffA); PG8_STAGE(PG8_SA(0, 1), cA + hstepA, voffA);
        if (wr == 1) PG8_BAR;
        PG8_WAIT_V(2); PG8_BAR;
        PG8_STAGE(PG8_SB(1, 0), cB + kstep, voffB); PG8_STAGE(PG8_SA(1, 0), cA + kstep, voffA); PG8_STAGE(PG8_SB(1, 1), cB + hstep + kstep, voffB);
        PG8_WAIT_V(6); PG8_BAR;
    } else {
        PG8_STAGE(PG8_SB(0, 0), cB, voffB); PG8_STAGE(PG8_SA(0, 0), cA, voffA); PG8_STAGE(PG8_SB(0, 1), cB + hstep, voffB); PG8_STAGE(PG8_SA(0, 1), cA + hstepA, voffA);
        if (wr == 1) PG8_BAR;
        PG8_WAIT_V(4); PG8_BAR;
        PG8_STAGE(PG8_SB(1, 0), cB + kstep, voffB); PG8_STAGE(PG8_SA(1, 0), cA + kstep, voffA); PG8_STAGE(PG8_SB(1, 1), cB + hstep + kstep, voffB);
        PG8_WAIT_V(6); PG8_BAR;
    }
    for (;;) {
        const bool has_next = S.next(ui + 1, nxt);
        const char* nA = has_next ? (const char*)g.A + (size_t)nxt.pm * tstep : cA; const char* nB = has_next ? (const char*)g.Bt + (size_t)nxt.pn * tstep : cB;
        for (int t = 0; t < nt; t += 2) {
            const bool last = (t == nt - 2);
            const char* a1 = cA + (size_t)(t + 1) * kstep;
            const char* a2 = last ? nA : cA + (size_t)(t + 2) * kstep; const char* b2 = last ? nB : cB + (size_t)(t + 2) * kstep;
            const char* a3 = a2 + kstep; const char* b3 = b2 + kstep;
            if (last && has_next) S.a_ready(nxt);
            if constexpr (SP2) {
            PG8_LDB(B0, 0, 0); PG8_LDB(B1, 0, 1); PG8_SCHED; PG8_LDA(At, 0, 0); PG8_STAGE(PG8_SA(1, 1), a1 + hstepA, voffA);
            PG8_WAIT_V(8); PG8_WAIT_L(0); PG8_BAR; PG8_MMA(0, 0, At, B0); PG8_MMA(0, 1, At, B1); PG8_BAR; PG8_SCHED;
            PG8_LDA(At, 0, 1); PG8_STAGE(PG8_SB(0, 0), b2, voffB); PG8_STAGE(PG8_SB(0, 1), b2 + hstep, voffB); PG8_STAGE(PG8_SA(0, 0), a2, voffA);
            PG8_WAIT_V(8); PG8_WAIT_L(0); PG8_BAR; PG8_MMA(1, 0, At, B0); PG8_MMA(1, 1, At, B1); PG8_BAR; PG8_SCHED;
            PG8_LDB(B0, 1, 0); PG8_LDB(B1, 1, 1); PG8_SCHED; PG8_LDA(At, 1, 0); PG8_STAGE(PG8_SA(0, 1), a2 + hstepA, voffA);
            PG8_WAIT_V(8); PG8_WAIT_L(0); PG8_BAR; PG8_MMA(0, 0, At, B0); PG8_MMA(0, 1, At, B1); PG8_BAR; PG8_SCHED;
            PG8_LDA(At, 1, 1); PG8_STAGE(PG8_SB(1, 0), b3, voffB); PG8_STAGE(PG8_SB(1, 1), b3 + hstep, voffB); PG8_STAGE(PG8_SA(1, 0), a3, voffA);
            PG8_WAIT_V(8); PG8_WAIT_L(0); PG8_BAR; PG8_MMA(1, 0, At, B0); PG8_MMA(1, 1, At, B1); PG8_BAR; PG8_SCHED;
            } else {
            PG8_LDB(B0, 0, 0); PG8_SCHED; PG8_LDA(At, 0, 0); PG8_STAGE(PG8_SA(1, 1), a1 + hstepA, voffA);
            PG8_WAIT_L(8); PG8_BAR; PG8_WAIT_L(0); PG8_MMA(0, 0, At, B0); PG8_BAR; PG8_SCHED;
            PG8_LDB(B1, 0, 1); PG8_STAGE(PG8_SB(0, 0), b2, voffB);
            PG8_BAR; PG8_WAIT_L(0); PG8_MMA(0, 1, At, B1); PG8_BAR;
            PG8_LDA(At, 0, 1); PG8_STAGE(PG8_SA(0, 0), a2, voffA);
            PG8_BAR; PG8_WAIT_L(0); PG8_MMA(1, 0, At, B0); PG8_BAR; PG8_SCHED;
            PG8_STAGE(PG8_SB(0, 1), b2 + hstep, voffB);
            PG8_WAIT_V(6); PG8_BAR; PG8_MMA(1, 1, At, B1); PG8_BAR;
            PG8_LDB(B0, 1, 0); PG8_SCHED; PG8_LDA(At, 1, 0); PG8_STAGE(PG8_SA(0, 1), a2 + hstepA, voffA);
            PG8_WAIT_L(8); PG8_BAR; PG8_WAIT_L(0); PG8_MMA(0, 0, At, B0); PG8_BAR; PG8_SCHED;
            PG8_LDB(B1, 1, 1); PG8_STAGE(PG8_SB(1, 0), b3, voffB);
            PG8_BAR; PG8_WAIT_L(0); PG8_MMA(0, 1, At, B1); PG8_BAR;
            PG8_LDA(At, 1, 1); PG8_STAGE(PG8_SA(1, 0), a3, voffA);
            PG8_BAR; PG8_WAIT_L(0); PG8_MMA(1, 0, At, B0); PG8_BAR; PG8_SCHED;
            PG8_STAGE(PG8_SB(1, 1), b3 + hstep, voffB);
            PG8_WAIT_V(6); PG8_BAR; PG8_MMA(1, 1, At, B1); PG8_BAR;
            }
        }
        if constexpr (ALIGN_EPI) { if (wr == 0) PG8_BAR; }
        if constexpr (!Epi::AFTER_DRAIN) { E(acc, cur, wr, wc, fr, fq); S.done(cur); }
        if (!has_next) break;
#pragma unroll
        for (int a = 0; a < 2; ++a)
#pragma unroll
            for (int b = 0; b < 2; ++b)
#pragma unroll
                for (int m = 0; m < 4; ++m)
#pragma unroll
                    for (int n = 0; n < 2; ++n) acc[a][b][m][n] = (f32x4){0.f, 0.f, 0.f, 0.f};
        cur = nxt; cA = nA; cB = nB; ++ui;
        if constexpr (ALIGN_EPI) { if (wr == 1) PG8_BAR; }
    }
    PG8_WAIT_V(0);
    if constexpr (!ALIGN_EPI) { if (wr == 0) PG8_BAR; }
    PG8_BAR;
    if constexpr (Epi::AFTER_DRAIN) { E.fused(acc, cur, wr, wc, fr, fq, lds, wid, lane); S.done(cur); }
#undef PG8_SA
#undef PG8_SB
#undef PG8_STAGE
#undef PG8_LDA
#undef PG8_LDB
#undef PG8_MMA
#undef PG8_WAIT_V
#undef PG8_WAIT_L
#undef PG8_BAR
#undef PG8_SCHED
}
}

#define LAS __attribute__((address_space(3)))
using pg8::bf16_t; using pg8::bf16x8; using pg8::f32x4; using pg8::u32x4;
typedef float f32x16 __attribute__((ext_vector_type(16)));
typedef unsigned u32x2 __attribute__((ext_vector_type(2)));
typedef __bf16 bf2_t __attribute__((ext_vector_type(2)));
typedef float f32x2 __attribute__((ext_vector_type(2)));

constexpr int NB = 32, SEQ = 2048, DM = 1024, NTOK = NB * SEQ, NIN = 3328, DH = 512, NPROJ = 1792;
constexpr int PJ_GH = 0, PJ_Q = 512, PJ_K = 1024, PJ_V = 1152, PJ_GA = 1280;
constexpr float EPS = 1e-6f;
constexpr size_t WS_WIN = 0;
constexpr size_t WS_WOUT = WS_WIN + (size_t)NIN * DM * 2;
constexpr size_t WS_RF = WS_WOUT + (size_t)DM * DM * 2;
constexpr size_t WS_ROPE = WS_RF + (size_t)2 * DH * 4096 * 2;
constexpr size_t WS_XB = WS_ROPE + (size_t)SEQ * 32 * 4 * 2;
constexpr size_t WS_HYT = WS_XB + (size_t)NTOK * DM * 2;
constexpr size_t WS_PROJ = WS_HYT + (size_t)1536 * NTOK * 2;
constexpr size_t WS_ZT = WS_PROJ + (size_t)NTOK * NPROJ * 2;
constexpr size_t WS_YA = WS_ZT + (size_t)DH * NTOK * 2;
constexpr size_t WS_Y = WS_YA + (size_t)NTOK * DH * 2;
constexpr size_t WS_CTL = WS_Y + (size_t)NTOK * DM * 2;
constexpr size_t WS_END = WS_CTL + 4096;
constexpr int LDS_BYTES = 144 * 1024;
constexpr int NTHREADS = 512;
#ifndef GEMM_ALIGN
#define GEMM_ALIGN true
#endif
#ifndef GEMM_SP2
#define GEMM_SP2 true
#endif

#define LDS_WAIT() asm volatile("s_waitcnt lgkmcnt(0)" ::: "memory")
#define MFMA32(a, b, c) __builtin_amdgcn_mfma_f32_32x32x16_bf16((a), (b), (c), 0, 0, 0)

__device__ __forceinline__ unsigned pk2(float lo, float hi) { f32x2 v = {lo, hi}; bf2_t b = __builtin_convertvector(v, bf2_t); return __builtin_bit_cast(unsigned, b); }
__device__ __forceinline__ float bf_lo(unsigned w) { return __uint_as_float(w << 16); }
__device__ __forceinline__ float bf_hi(unsigned w) { return __uint_as_float(w & 0xffff0000u); }
__device__ __forceinline__ float bf1(bf16_t v) { return __uint_as_float(((unsigned)v) << 16); }
__device__ __forceinline__ float wave_sum(float v) {
#pragma unroll
    for (int o = 1; o < 64; o <<= 1) v += __shfl_xor(v, o);
    return v;
}

__device__ __forceinline__ float sin_acc(float x) { double r = (double)x * 0.15915494309189535; r -= rint(r); return __builtin_amdgcn_sinf((float)r); }
__device__ __forceinline__ float cos_acc(float x) { double r = (double)x * 0.15915494309189535; r -= rint(r); return __builtin_amdgcn_cosf((float)r); }
__device__ __forceinline__ float silu_f(float v) { return v * __builtin_amdgcn_rcpf(1.0f + __expf(-v)); }

struct EpiIn {
    static constexpr bool PERM = true, APERM = true, AFTER_DRAIN = false;
    bf16_t* hyt; bf16_t* proj;
    __device__ __forceinline__ void prefetch(const pg8::Unit&, int, float (&)[4]) const {}
    __device__ __forceinline__ void prefetch_done(float (&)[4]) const {}
    __device__ __forceinline__ void operator()(const f32x4 (&acc)[2][2][4][2], const pg8::Unit& u, int wr, int wc, int fr, int fq) const {
        const int tok0 = u.pm * 256 + wr * 128 + 8 * fr;
        if (u.pn < 6) {
            const int col0 = u.pn * 256 + wc * 32 + 8 * fq;
#pragma unroll
            for (int bj = 0; bj < 2; ++bj)
#pragma unroll
                for (int n = 0; n < 2; ++n)
#pragma unroll
                    for (int j = 0; j < 4; ++j) {
                        const int col = col0 + bj * 128 + 4 * n + j;
                        u32x4 w;
                        w.x = pk2(acc[0][bj][0][n][j], acc[0][bj][1][n][j]); w.y = pk2(acc[0][bj][2][n][j], acc[0][bj][3][n][j]);
                        w.z = pk2(acc[1][bj][0][n][j], acc[1][bj][1][n][j]); w.w = pk2(acc[1][bj][2][n][j], acc[1][bj][3][n][j]);
                        *(u32x4*)(hyt + (size_t)col * NTOK + tok0) = w;
                    }
        } else {
            const int pc0 = u.pn * 256 - 1536 + wc * 32 + 8 * fq;
#pragma unroll
            for (int ai = 0; ai < 2; ++ai)
#pragma unroll
                for (int m = 0; m < 4; ++m) {
                    bf16_t* rowp = proj + (size_t)(tok0 + 4 * ai + m) * NPROJ + pc0;
#pragma unroll
                    for (int bj = 0; bj < 2; ++bj) {
                        const f32x4 v0 = acc[ai][bj][m][0], v1 = acc[ai][bj][m][1];
                        u32x4 w; w.x = pk2(v0[0], v0[1]); w.y = pk2(v0[2], v0[3]); w.z = pk2(v1[0], v1[1]); w.w = pk2(v1[2], v1[3]);
                        *(u32x4*)(rowp + bj * 128) = w;
                    }
                }
        }
    }
};
struct EpiOut {
    static constexpr bool PERM = false, APERM = false, AFTER_DRAIN = false;
    const float* x; float* out;
    __device__ __forceinline__ void prefetch(const pg8::Unit& u, int tid, float (&pf)[4]) const {
#pragma unroll
        for (int i = 0; i < 4; ++i) { const int line = tid + 512 * i, r = line >> 3, c = (line & 7) * 32; pf[i] = x[(size_t)(u.pm * 256 + r) * DM + u.pn * 256 + c]; }
    }
    __device__ __forceinline__ void prefetch_done(float (&pf)[4]) const { asm volatile("" :: "v"(pf[0]), "v"(pf[1]), "v"(pf[2]), "v"(pf[3])); }
    __device__ __forceinline__ void operator()(const f32x4 (&acc)[2][2][4][2], const pg8::Unit& u, int wr, int wc, int fr, int fq) const {
        const int row0 = u.pm * 256 + wr * 64 + fr, col0 = u.pn * 256 + wc * 32 + 4 * fq;
        const float* xb = x + (size_t)row0 * DM + col0; float* ob = out + (size_t)row0 * DM + col0;
#pragma unroll
        for (int ai = 0; ai < 2; ++ai)
#pragma unroll
            for (int mp = 0; mp < 2; ++mp) {
                f32x4 xv[2][2][2];
#pragma unroll
                for (int mm = 0; mm < 2; ++mm)
#pragma unroll
                    for (int bj = 0; bj < 2; ++bj)
#pragma unroll
                        for (int n = 0; n < 2; ++n) xv[mm][bj][n] = *(const f32x4*)(xb + (size_t)(ai * 128 + (2 * mp + mm) * 16) * DM + bj * 128 + n * 16);
                __builtin_amdgcn_sched_barrier(0);
#pragma unroll
                for (int mm = 0; mm < 2; ++mm)
#pragma unroll
                    for (int bj = 0; bj < 2; ++bj)
#pragma unroll
                        for (int n = 0; n < 2; ++n) *(f32x4*)(ob + (size_t)(ai * 128 + (2 * mp + mm) * 16) * DM + bj * 128 + n * 16) = xv[mm][bj][n] + acc[ai][bj][2 * mp + mm][n];
                __builtin_amdgcn_sched_barrier(0);
            }
    }
};

__device__ __forceinline__ void p0_transpose_item(const float* W, const float* gk, int K, int N, bf16_t* WT, LAS float* scr, int item, int lane) {
    const int nblk = N / 32, kb = item / nblk, nb = item % nblk, k0 = 64 * kb, n0 = 32 * nb;
#pragma unroll 8
    for (int i = 0; i < 32; ++i) { const int kk = 2 * i + (lane >> 5); scr[kk * 33 + (lane & 31)] = W[(size_t)(k0 + kk) * N + n0 + (lane & 31)] * gk[k0 + kk]; }
    LDS_WAIT();
    const int c = lane & 7;
#pragma unroll
    for (int j = 0; j < 4; ++j) {
        const int n = (lane >> 3) + 8 * j; const LAS float* s = scr + (8 * c) * 33 + n;
        u32x4 o; o.x = pk2(s[0 * 33], s[1 * 33]); o.y = pk2(s[2 * 33], s[3 * 33]); o.z = pk2(s[4 * 33], s[5 * 33]); o.w = pk2(s[6 * 33], s[7 * 33]);
        *(u32x4*)(WT + (size_t)(n0 + n) * K + k0 + 8 * c) = o;
    }
    LDS_WAIT();
}

struct Params { const float* in[20]; float* out; unsigned char* ws; };

__device__ __forceinline__ void p0_prologue(const Params& p, LAS unsigned char* lds, int tid, int wave, int lane) {
    LAS float* scr = (LAS float*)(lds + wave * 16384);
    const int gw = blockIdx.x * 8 + wave, NGW = gridDim.x * 8;
    bf16_t* WinT = (bf16_t*)(p.ws + WS_WIN); bf16_t* WoutT = (bf16_t*)(p.ws + WS_WOUT); bf16_t* RF = (bf16_t*)(p.ws + WS_RF);
    float* ROPE = (float*)(p.ws + WS_ROPE); bf16_t* XB = (bf16_t*)(p.ws + WS_XB);
    constexpr int I_IN = (DM / 64) * (NIN / 32);
#pragma unroll 1
    for (int it = gw; it < I_IN; it += NGW) p0_transpose_item(p.in[2], p.in[1], DM, NIN, WinT, scr, it, lane);
    __syncthreads();
    {
        const float* w1 = p.in[5]; const float* b1 = p.in[6]; const float* w2 = p.in[7]; const float* b2 = p.in[8];
        const float* w3 = p.in[9]; const float* b3 = p.in[10]; const float* w4 = p.in[11]; const float* sf = p.in[12];
        const float* hbias = p.in[13];
#pragma unroll 1
        for (int l = gw; l < SEQ; l += NGW) {
            const float t = (float)l / 2047.0f;
            const float w = 6.283185307179586f * (float)l / 2048.0f;
            if (lane < 33) {
                float zi;
                if (lane == 0) zi = t;
                else { const int i = (lane - 1) & 15; const float f = 1e-4f + (float)i * ((15.0f - 1e-4f) / 15.0f); const float a = f * w; zi = (lane <= 16) ? cos_acc(a) : -sin_acc(a); }
                scr[lane] = zi;
            }
            LDS_WAIT();
            const float fr = sf[lane];
            float a = b1[lane];
#pragma unroll 11
            for (int i = 0; i < 33; ++i) a += scr[i] * w1[i * 64 + lane];
            scr[64 + lane] = sin_acc(fr * a);
            LDS_WAIT();
            a = b2[lane];
#pragma unroll 16
            for (int i = 0; i < 64; ++i) a += scr[64 + i] * w2[i * 64 + lane];
            scr[128 + lane] = sin_acc(fr * a);
            LDS_WAIT();
            a = b3[lane];
#pragma unroll 16
            for (int i = 0; i < 64; ++i) a += scr[128 + i] * w3[i * 64 + lane];
            scr[192 + lane] = sin_acc(fr * a);
            LDS_WAIT();
            {
                f32x4 acc4[8];
#pragma unroll
                for (int i = 0; i < 8; ++i) acc4[i] = (f32x4){0.f, 0.f, 0.f, 0.f};
                const f32x4* w4v = (const f32x4*)w4;
                f32x4 stg[8];
#pragma unroll
                for (int q = 0; q < 8; ++q) stg[q] = w4v[tid + 512 * q];
#pragma unroll 1
                for (int jc = 0; jc < 64; jc += 8) {
                    __syncthreads();
#pragma unroll
                    for (int q = 0; q < 8; ++q) { const int idx = tid + 512 * q; *(LAS f32x4*)(lds + (idx >> 9) * 16384 + 8192 + (idx & 511) * 16) = stg[q]; }
                    if (jc + 8 < 64) {
#pragma unroll
                        for (int q = 0; q < 8; ++q) stg[q] = w4v[(jc + 8) * 512 + tid + 512 * q];
                    }
                    __syncthreads();
#pragma unroll
                    for (int jj = 0; jj < 8; ++jj) {
                        const float hj = scr[192 + jc + jj];
                        const LAS f32x4* wr4 = (const LAS f32x4*)(lds + jj * 16384 + 8192) + lane;
#pragma unroll
                        for (int i = 0; i < 8; ++i) acc4[i] += hj * wr4[64 * i];
                    }
                }
#pragma unroll
                for (int i = 0; i < 8; ++i) {
                    float val[4];
#pragma unroll
                    for (int e = 0; e < 4; ++e) {
                        const int n = 4 * lane + 256 * i + e;
                        const int o = n >> 10, dir = (n >> 9) & 1, c = n & 511;
                        const float ad = 3.0701134573f + (float)c * ((15.3505672866f - 3.0701134573f) / 511.0f);
                        val[e] = acc4[i][e] * __expf(-t * ad);
                        if (l == 0 && dir == 0) val[e] += hbias[o * 512 + c];
                    }
                    u32x2 w; w.x = pk2(val[0], val[1]); w.y = pk2(val[2], val[3]);
                    *(u32x2*)(RF + (size_t)l * 2048 + 4 * lane + 256 * i) = w;
                }
            }
            LDS_WAIT();
        }
    }
    for (int idx = blockIdx.x * NTHREADS + tid; idx < SEQ * 32; idx += gridDim.x * NTHREADS) {
        const int pos = idx >> 5, i = idx & 31;
        const float inv = exp2f(-(float)i * (13.287712379549449f / 32.0f));
        const float ang = (float)pos * inv;
        ROPE[idx] = cos_acc(ang); ROPE[SEQ * 32 + idx] = sin_acc(ang);
    }
    {
        const float* x = p.in[0];
#pragma unroll 1
        for (int m = gw; m < NTOK; m += 2 * NGW) {
            const int m2 = m + NGW;
            const bool has2 = m2 < NTOK;
            const f32x4* xr = (const f32x4*)(x + (size_t)m * DM) + lane;
            const f32x4* xr2 = (const f32x4*)(x + (size_t)(has2 ? m2 : m) * DM) + lane;
            f32x4 v[4], v2[4]; float s = 0.f, s2 = 0.f;
#pragma unroll
            for (int j = 0; j < 4; ++j) { v[j] = __builtin_nontemporal_load(xr + 64 * j); v2[j] = __builtin_nontemporal_load(xr2 + 64 * j); }
#pragma unroll
            for (int j = 0; j < 4; ++j) { s += (v[j].x * v[j].x + v[j].y * v[j].y) + (v[j].z * v[j].z + v[j].w * v[j].w); s2 += (v2[j].x * v2[j].x + v2[j].y * v2[j].y) + (v2[j].z * v2[j].z + v2[j].w * v2[j].w); }
            const float rstd = 1.0f / sqrtf(wave_sum(s) * (1.0f / DM) + EPS), rstd2 = 1.0f / sqrtf(wave_sum(s2) * (1.0f / DM) + EPS);
            u32x2* o8 = (u32x2*)(XB + (size_t)m * DM) + lane;
#pragma unroll
            for (int j = 0; j < 4; ++j) { u32x2 w; w.x = pk2(v[j].x * rstd, v[j].y * rstd); w.y = pk2(v[j].z * rstd, v[j].w * rstd); o8[64 * j] = w; }
            if (has2) {
                u32x2* o82 = (u32x2*)(XB + (size_t)m2 * DM) + lane;
#pragma unroll
                for (int j = 0; j < 4; ++j) { u32x2 w; w.x = pk2(v2[j].x * rstd2, v2[j].y * rstd2); w.y = pk2(v2[j].z * rstd2, v2[j].w * rstd2); o82[64 * j] = w; }
            }
        }
    }
}

constexpr int UROWB = 4112;
constexpr int HY_R_OFF = 32 * UROWB;

__device__ __forceinline__ bf16x8 load_afrag(const LAS unsigned* Rw, int n0) {
    const int dw = n0 >> 1; const unsigned sh = (unsigned)(n0 & 1) << 4;
    const unsigned d0 = Rw[dw], d1 = Rw[dw + 1], d2 = Rw[dw + 2], d3 = Rw[dw + 3], d4 = Rw[dw + 4];
    u32x4 f;
    f.x = __builtin_amdgcn_alignbit(d1, d0, sh); f.y = __builtin_amdgcn_alignbit(d2, d1, sh);
    f.z = __builtin_amdgcn_alignbit(d3, d2, sh); f.w = __builtin_amdgcn_alignbit(d4, d3, sh);
    return __builtin_bit_cast(bf16x8, f);
}
__device__ __forceinline__ void hy_conv(f32x16 (&acc)[8], const LAS unsigned char* lds, int wave, int i32, int h) {
    const LAS unsigned* Rw = (const LAS unsigned*)(lds + HY_R_OFF);
    const LAS unsigned char* Ub = lds + i32 * UROWB + 16 * h;
    const int nbase = 2048 - 256 * wave - i32 + 8 * h;
    bf16x8 AE[8], AO[8];
#pragma unroll
    for (int r = 0; r < 8; ++r) {
#pragma unroll
        for (int i = 0; i < 16; ++i) acc[r][i] = 0.f;
        AE[r] = load_afrag(Rw, nbase - 32 * r); AO[r] = load_afrag(Rw, nbase - 32 * r + 16);
    }
    for (int P = 0; P < 8; ++P) {
#pragma unroll
        for (int p = 0; p < 8; ++p) {
            const int S = 8 * P + p;
            const bf16x8 Be = *(const LAS bf16x8*)(Ub + 64 * S), Bo = *(const LAS bf16x8*)(Ub + 64 * S + 32);
#pragma unroll
            for (int r = 0; r < 8; ++r) {
                acc[r] = MFMA32(AE[(r - p) & 7], Be, acc[r]);
                acc[r] = MFMA32(AO[(r - p) & 7], Bo, acc[r]);
            }
            if (S + 1 < 64) { AE[(7 - p) & 7] = load_afrag(Rw, nbase + 32 * (S + 1)); AO[(7 - p) & 7] = load_afrag(Rw, nbase + 32 * (S + 1) + 16); }
        }
    }
}

__device__ __forceinline__ void hy_stage(LAS unsigned char* lds, const bf16_t* hy, float w0, float w1, float w2, float bias, int tid) {
#pragma unroll 4
    for (int ch = tid; ch < 8192; ch += NTHREADS) {
        const int b = ch >> 8, t0 = (ch & 255) << 3; const bf16_t* row = hy + b * SEQ;
        const u32x4 v = *(const u32x4*)(row + t0);
        float x[10];
        x[0] = bf1(row[(t0 > 0) ? t0 - 1 : 0]); x[9] = bf1(row[(t0 + 8 < SEQ) ? t0 + 8 : SEQ - 1]);
        x[0] = (t0 > 0) ? x[0] : 0.f; x[9] = (t0 + 8 < SEQ) ? x[9] : 0.f;
        x[1] = bf_lo(v.x); x[2] = bf_hi(v.x); x[3] = bf_lo(v.y); x[4] = bf_hi(v.y); x[5] = bf_lo(v.z); x[6] = bf_hi(v.z); x[7] = bf_lo(v.w); x[8] = bf_hi(v.w);
        float o[8];
#pragma unroll
        for (int j = 0; j < 8; ++j) o[j] = bias + w0 * x[j] + w1 * x[j + 1] + w2 * x[j + 2];
        u32x4 w; w.x = pk2(o[0], o[1]); w.y = pk2(o[2], o[3]); w.z = pk2(o[4], o[5]); w.w = pk2(o[6], o[7]);
        *(LAS u32x4*)(lds + b * UROWB + t0 * 2) = w;
    }
}
__device__ __forceinline__ void hy_gate_inplace(LAS unsigned char* lds, const f32x16 (&acc)[8], int wave, int i32, int h) {
    LAS unsigned char* lp = lds + i32 * UROWB + (256 * wave + 4 * h) * 2;
#pragma unroll
    for (int r = 0; r < 8; ++r)
#pragma unroll
        for (int g = 0; g < 4; ++g) {
            LAS u32x2* up = (LAS u32x2*)(lp + (32 * r + 8 * g) * 2);
            const u32x2 uu = *up;
            u32x2 w; w.x = pk2(bf_lo(uu.x) * acc[r][4 * g + 0], bf_hi(uu.x) * acc[r][4 * g + 1]); w.y = pk2(bf_lo(uu.y) * acc[r][4 * g + 2], bf_hi(uu.y) * acc[r][4 * g + 3]);
            *up = w;
        }
}
__device__ __forceinline__ void hy_load_filter(LAS unsigned char* lds, const bf16_t* RF, int o, int c, int tid) {
    unsigned v[8];
#pragma unroll
    for (int j = 0; j < 8; ++j) {
        const int n = 8 * tid + j;
        const int dir = (n > 2048) ? 1 : 0, l = (n > 2048) ? n - 2048 : 2048 - n;
        const int ll = (l > 2047) ? 2047 : l;
        v[j] = RF[(size_t)ll * 2048 + (o * 2 + dir) * 512 + c];
        if (n == 0) v[j] = 0u;
    }
    u32x4 w; w.x = v[0] | (v[1] << 16); w.y = v[2] | (v[3] << 16); w.z = v[4] | (v[5] << 16); w.w = v[6] | (v[7] << 16);
    *(LAS u32x4*)(lds + HY_R_OFF + tid * 16) = w;
}
__device__ __forceinline__ void hyena_unit(const Params& p, LAS unsigned char* lds, int c, int tid, int wave, int lane) {
    const bf16_t* HYT = (const bf16_t*)(p.ws + WS_HYT); const bf16_t* RF = (const bf16_t*)(p.ws + WS_RF); bf16_t* ZT = (bf16_t*)(p.ws + WS_ZT);
    const float* cw = p.in[3]; const float* cb = p.in[4];
    asm volatile("" : "+v"(tid), "+v"(lane));
    int i32 = lane & 31, h = lane >> 5;
    hy_stage(lds, HYT + (size_t)c * NTOK, cw[c], cw[1536 + c], cw[3072 + c], cb[c], tid);
    hy_load_filter(lds, RF, 0, c, tid);
    if (tid < 4) *(LAS unsigned*)(lds + HY_R_OFF + 8192 + tid * 4) = 0u;
    __syncthreads();
    f32x16 acc[8];
    hy_conv(acc, lds, wave, i32, h);
    __syncthreads();
    asm volatile("" : "+v"(tid), "+v"(i32), "+v"(h));
    hy_stage(lds, HYT + (size_t)(512 + c) * NTOK, cw[512 + c], cw[1536 + 512 + c], cw[3072 + 512 + c], cb[512 + c], tid);
    hy_load_filter(lds, RF, 1, c, tid);
    __syncthreads();
    hy_gate_inplace(lds, acc, wave, i32, h);
    __syncthreads();
    hy_conv(acc, lds, wave, i32, h);
    __syncthreads();
    asm volatile("" : "+v"(tid), "+v"(i32), "+v"(h));
    hy_stage(lds, HYT + (size_t)(1024 + c) * NTOK, cw[1024 + c], cw[1536 + 1024 + c], cw[3072 + 1024 + c], cb[1024 + c], tid);
    __syncthreads();
    hy_gate_inplace(lds, acc, wave, i32, h);
    __syncthreads();
    {
        bf16_t* zt = ZT + (size_t)c * NTOK;
#pragma unroll 4
        for (int ch = tid; ch < 8192; ch += NTHREADS) {
            const int b = ch >> 8, t0 = (ch & 255) << 3;
            *(u32x4*)(zt + b * SEQ + t0) = *(const LAS u32x4*)(lds + b * UROWB + t0 * 2);
        }
    }
    __syncthreads();
}

constexpr int KROWB = 144;
constexpr int VROWB = 792;
constexpr int AT_V_OFF = 384 * KROWB;

__device__ __forceinline__ void attn_unit(const Params& p, LAS unsigned char* lds, int unit, int tid, int wave, int lane) {
    const bf16_t* proj = (const bf16_t*)(p.ws + WS_PROJ); const float* ROPE = (const float*)(p.ws + WS_ROPE); bf16_t* YA = (bf16_t*)(p.ws + WS_YA);
    const float* qg = p.in[14]; const float* kg = p.in[15]; const float* sink = p.in[16];
    const int b = unit >> 4, start = (unit & 15) * 128;
    asm volatile("" : "+v"(tid), "+v"(lane));
    const int i32 = lane & 31, h = lane >> 5;
    const float* RC = ROPE; const float* RS = ROPE + SEQ * 32;
    for (int kvh = 0; kvh < 2; ++kvh) {
#pragma unroll
        for (int task = tid; task < 1536; task += NTHREADS) {
            const int kk = task >> 2, c4 = task & 3, kp = start - 128 + kk;
            const bool valid = (kp >= 0) && (kp < SEQ);
            float x1[8], x2[8]; float ss = 0.f;
            if (valid) {
                const bf16_t* src = proj + (size_t)(b * SEQ + kp) * NPROJ + PJ_K + kvh * 64 + 8 * c4;
                const u32x4 a = *(const u32x4*)src, bq = *(const u32x4*)(src + 32);
                x1[0] = bf_lo(a.x); x1[1] = bf_hi(a.x); x1[2] = bf_lo(a.y); x1[3] = bf_hi(a.y); x1[4] = bf_lo(a.z); x1[5] = bf_hi(a.z); x1[6] = bf_lo(a.w); x1[7] = bf_hi(a.w);
                x2[0] = bf_lo(bq.x); x2[1] = bf_hi(bq.x); x2[2] = bf_lo(bq.y); x2[3] = bf_hi(bq.y); x2[4] = bf_lo(bq.z); x2[5] = bf_hi(bq.z); x2[6] = bf_lo(bq.w); x2[7] = bf_hi(bq.w);
#pragma unroll
                for (int j = 0; j < 8; ++j) ss += x1[j] * x1[j] + x2[j] * x2[j];
            } else {
#pragma unroll
                for (int j = 0; j < 8; ++j) { x1[j] = 0.f; x2[j] = 0.f; }
            }
            ss += __shfl_xor(ss, 1); ss += __shfl_xor(ss, 2);
            u32x4 o1 = {0u, 0u, 0u, 0u}, o2 = {0u, 0u, 0u, 0u};
            if (valid) {
                const float rstd = 1.0f / sqrtf(ss * (1.0f / 64.0f) + EPS);
                const f32x4 c0 = *(const f32x4*)(RC + kp * 32 + 8 * c4), c1 = *(const f32x4*)(RC + kp * 32 + 8 * c4 + 4);
                const f32x4 s0 = *(const f32x4*)(RS + kp * 32 + 8 * c4), s1 = *(const f32x4*)(RS + kp * 32 + 8 * c4 + 4);
                float r1[8], r2[8];
#pragma unroll
                for (int j = 0; j < 8; ++j) {
                    const float cc = (j < 4) ? c0[j & 3] : c1[j & 3], sn = (j < 4) ? s0[j & 3] : s1[j & 3];
                    const float a1 = x1[j] * rstd * kg[8 * c4 + j], a2 = x2[j] * rstd * kg[32 + 8 * c4 + j];
                    r1[j] = a1 * cc - a2 * sn; r2[j] = a2 * cc + a1 * sn;
                }
                o1.x = pk2(r1[0], r1[1]); o1.y = pk2(r1[2], r1[3]); o1.z = pk2(r1[4], r1[5]); o1.w = pk2(r1[6], r1[7]);
                o2.x = pk2(r2[0], r2[1]); o2.y = pk2(r2[2], r2[3]); o2.z = pk2(r2[4], r2[5]); o2.w = pk2(r2[6], r2[7]);
            }
            *(LAS u32x4*)(lds + kk * KROWB + 16 * c4) = o1;
            *(LAS u32x4*)(lds + kk * KROWB + 64 + 16 * c4) = o2;
        }
#pragma unroll
        for (int it = 0; it < 2; ++it) {
            const int task = tid + it * NTHREADS;
            if (task < 768) {
                const int kg = task >> 3, c8 = task & 7, kk = 4 * kg, kp = start - 128 + kk;
                u32x4 a0 = {0u, 0u, 0u, 0u}, a1 = a0, a2 = a0, a3 = a0;
                if (kp >= 0 && kp < SEQ) {
                    const bf16_t* src = proj + (size_t)(b * SEQ + kp) * NPROJ + PJ_V + kvh * 64 + 8 * c8;
                    a0 = *(const u32x4*)src; a1 = *(const u32x4*)(src + NPROJ); a2 = *(const u32x4*)(src + 2 * NPROJ); a3 = *(const u32x4*)(src + 3 * NPROJ);
                }
                LAS unsigned char* dst = lds + AT_V_OFF + (8 * c8) * VROWB + kk * 2;
#pragma unroll
                for (int w = 0; w < 4; ++w) {
                    u32x2 lo, hi;
                    lo.x = __builtin_amdgcn_perm(a1[w], a0[w], 0x05040100u); lo.y = __builtin_amdgcn_perm(a3[w], a2[w], 0x05040100u);
                    hi.x = __builtin_amdgcn_perm(a1[w], a0[w], 0x07060302u); hi.y = __builtin_amdgcn_perm(a3[w], a2[w], 0x07060302u);
                    *(LAS u32x2*)(dst + (2 * w) * VROWB) = lo;
                    *(LAS u32x2*)(dst + (2 * w + 1) * VROWB) = hi;
                }
            }
        }
        const int g = wave >> 1, half = wave & 1, hq = kvh * 4 + g, p0 = start + 64 * half;
        u32x4 qraw[2][4];
#pragma unroll
        for (int qt = 0; qt < 2; ++qt) {
            const bf16_t* src = proj + (size_t)(b * SEQ + p0 + 32 * qt + i32) * NPROJ + PJ_Q + hq * 64 + 8 * h;
#pragma unroll
            for (int ks = 0; ks < 4; ++ks) qraw[qt][ks] = *(const u32x4*)(src + 16 * ks);
        }
        __syncthreads();
        bf16x8 qf[2][4];
#pragma unroll
        for (int qt = 0; qt < 2; ++qt) {
            const int pos = p0 + 32 * qt + i32;
            float x[4][8]; float ss = 0.f;
#pragma unroll
            for (int ks = 0; ks < 4; ++ks) {
                const u32x4 a = qraw[qt][ks];
                x[ks][0] = bf_lo(a.x); x[ks][1] = bf_hi(a.x); x[ks][2] = bf_lo(a.y); x[ks][3] = bf_hi(a.y); x[ks][4] = bf_lo(a.z); x[ks][5] = bf_hi(a.z); x[ks][6] = bf_lo(a.w); x[ks][7] = bf_hi(a.w);
#pragma unroll
                for (int j = 0; j < 8; ++j) ss += x[ks][j] * x[ks][j];
            }
            ss += __shfl_xor(ss, 32);
            const float rstd = (0.125f * 1.4426950408889634f) / sqrtf(ss * (1.0f / 64.0f) + EPS);
#pragma unroll
            for (int ks = 0; ks < 2; ++ks) {
                const int d1 = 16 * ks + 8 * h;
                const f32x4 c0 = *(const f32x4*)(RC + pos * 32 + d1), c1 = *(const f32x4*)(RC + pos * 32 + d1 + 4);
                const f32x4 s0 = *(const f32x4*)(RS + pos * 32 + d1), s1 = *(const f32x4*)(RS + pos * 32 + d1 + 4);
#pragma unroll
                for (int j = 0; j < 8; ++j) {
                    const float cc = (j < 4) ? c0[j & 3] : c1[j & 3], sn = (j < 4) ? s0[j & 3] : s1[j & 3];
                    const float a1 = x[ks][j] * rstd * qg[d1 + j], a2 = x[ks + 2][j] * rstd * qg[d1 + 32 + j];
                    x[ks][j] = a1 * cc - a2 * sn; x[ks + 2][j] = a2 * cc + a1 * sn;
                }
            }
#pragma unroll
            for (int ks = 0; ks < 4; ++ks) {
                u32x4 w; w.x = pk2(x[ks][0], x[ks][1]); w.y = pk2(x[ks][2], x[ks][3]); w.z = pk2(x[ks][4], x[ks][5]); w.w = pk2(x[ks][6], x[ks][7]);
                qf[qt][ks] = __builtin_bit_cast(bf16x8, w);
            }
        }
        const float sink2 = sink[hq] * 1.4426950408889634f;
        float mrun[2] = {sink2, sink2}, lrun[2] = {1.0f, 1.0f};
        f32x16 o[2][2];
#pragma unroll
        for (int a = 0; a < 2; ++a)
#pragma unroll
            for (int c = 0; c < 2; ++c)
#pragma unroll
                for (int i = 0; i < 16; ++i) o[a][c][i] = 0.f;
        for (int jt = 0; jt < 5; ++jt) {
            const int kk0 = 64 * half + 64 * jt, kp0 = start - 128 + kk0;
            if (kp0 + 63 < 0 || kp0 >= SEQ) continue;
            const bool need_mask = (jt == 0) || (jt == 4) || (kp0 < 0) || (kp0 + 64 > SEQ);
            f32x16 st[2][2];
#pragma unroll
            for (int a = 0; a < 2; ++a)
#pragma unroll
                for (int c = 0; c < 2; ++c)
#pragma unroll
                    for (int i = 0; i < 16; ++i) st[a][c][i] = 0.f;
#pragma unroll
            for (int ks = 0; ks < 4; ++ks) {
                const bf16x8 kf0 = *(const LAS bf16x8*)(lds + (kk0 + i32) * KROWB + (16 * ks + 8 * h) * 2);
                const bf16x8 kf1 = *(const LAS bf16x8*)(lds + (kk0 + 32 + i32) * KROWB + (16 * ks + 8 * h) * 2);
#pragma unroll
                for (int qt = 0; qt < 2; ++qt) { st[0][qt] = MFMA32(kf0, qf[qt][ks], st[0][qt]); st[1][qt] = MFMA32(kf1, qf[qt][ks], st[1][qt]); }
            }
#pragma unroll
            for (int qt = 0; qt < 2; ++qt) {
                const int qpos = p0 + 32 * qt + i32;
                float mx = -INFINITY;
#pragma unroll
                for (int mt = 0; mt < 2; ++mt)
#pragma unroll
                    for (int i = 0; i < 16; ++i) {
                        float s = st[mt][qt][i];
                        if (need_mask) {
                            const int kp = kp0 + 32 * mt + (i & 3) + 8 * (i >> 2) + 4 * h;
                            const int dlt = kp - qpos;
                            const bool ok = (kp >= 0) && (kp < SEQ) && (dlt <= 128) && (dlt >= -128);
                            s = ok ? s : -INFINITY;
                            st[mt][qt][i] = s;
                        }
                        mx = fmaxf(mx, s);
                    }
                mx = fmaxf(mx, __shfl_xor(mx, 32));
                const float mnew = fmaxf(mrun[qt], mx);
                const float alpha = __builtin_amdgcn_exp2f(mrun[qt] - mnew);
                mrun[qt] = mnew;
                float rs = 0.f;
#pragma unroll
                for (int mt = 0; mt < 2; ++mt)
#pragma unroll
                    for (int i = 0; i < 16; ++i) { const float pv = __builtin_amdgcn_exp2f(st[mt][qt][i] - mnew); st[mt][qt][i] = pv; rs += pv; }
                rs += __shfl_xor(rs, 32);
                lrun[qt] = lrun[qt] * alpha + rs;
#pragma unroll
                for (int i = 0; i < 16; ++i) { o[0][qt][i] *= alpha; o[1][qt][i] *= alpha; }
            }
#pragma unroll
            for (int mt = 0; mt < 2; ++mt)
#pragma unroll
                for (int s2 = 0; s2 < 2; ++s2) {
                    bf16x8 pf[2];
#pragma unroll
                    for (int qt = 0; qt < 2; ++qt) {
                        u32x4 w; w.x = pk2(st[mt][qt][8 * s2 + 0], st[mt][qt][8 * s2 + 1]); w.y = pk2(st[mt][qt][8 * s2 + 2], st[mt][qt][8 * s2 + 3]);
                        w.z = pk2(st[mt][qt][8 * s2 + 4], st[mt][qt][8 * s2 + 5]); w.w = pk2(st[mt][qt][8 * s2 + 6], st[mt][qt][8 * s2 + 7]);
                        pf[qt] = __builtin_bit_cast(bf16x8, w);
                    }
                    const int kb = kk0 + 32 * mt + 16 * s2 + 4 * h;
#pragma unroll
                    for (int dt = 0; dt < 2; ++dt) {
                        const LAS unsigned char* vp = lds + AT_V_OFF + (32 * dt + i32) * VROWB + kb * 2;
                        const u32x2 lo = *(const LAS u32x2*)vp, hi = *(const LAS u32x2*)(vp + 16);
                        u32x4 w; w.x = lo.x; w.y = lo.y; w.z = hi.x; w.w = hi.y;
                        const bf16x8 vf = __builtin_bit_cast(bf16x8, w);
#pragma unroll
                        for (int qt = 0; qt < 2; ++qt) o[dt][qt] = MFMA32(vf, pf[qt], o[dt][qt]);
                    }
                }
        }
#pragma unroll
        for (int qt = 0; qt < 2; ++qt) {
            const float inv = 1.0f / lrun[qt];
            bf16_t* dst = YA + (size_t)(b * SEQ + p0 + 32 * qt + i32) * DH + hq * 64 + 4 * h;
#pragma unroll
            for (int dt = 0; dt < 2; ++dt)
#pragma unroll
                for (int g4 = 0; g4 < 4; ++g4) {
                    u32x2 w; w.x = pk2(o[dt][qt][4 * g4 + 0] * inv, o[dt][qt][4 * g4 + 1] * inv); w.y = pk2(o[dt][qt][4 * g4 + 2] * inv, o[dt][qt][4 * g4 + 3] * inv);
                    *(u32x2*)(dst + 32 * dt + 8 * g4) = w;
                }
        }
        __syncthreads();
    }
}

constexpr int TROWB = 1028;
__device__ __forceinline__ void p3_unit(const Params& p, LAS unsigned char* lds, int unit, int tid, int wave, int lane) {
    const bf16_t* ZT = (const bf16_t*)(p.ws + WS_ZT); const bf16_t* YA = (const bf16_t*)(p.ws + WS_YA); const bf16_t* proj = (const bf16_t*)(p.ws + WS_PROJ);
    bf16_t* Y = (bf16_t*)(p.ws + WS_Y);
    const int tok0 = unit * 64;
#pragma unroll 4
    for (int task = tid; task < 2048; task += NTHREADS) {
        const int cp = task >> 3, ch = task & 7;
        const u32x4 v0 = *(const u32x4*)(ZT + (size_t)(2 * cp) * NTOK + tok0 + 8 * ch), v1 = *(const u32x4*)(ZT + (size_t)(2 * cp + 1) * NTOK + tok0 + 8 * ch);
        LAS unsigned char* dst = lds + (8 * ch) * TROWB + 4 * cp;
#pragma unroll
        for (int w = 0; w < 4; ++w) {
            *(LAS unsigned*)(dst + (2 * w) * TROWB) = __builtin_amdgcn_perm(v1[w], v0[w], 0x05040100u);
            *(LAS unsigned*)(dst + (2 * w + 1) * TROWB) = __builtin_amdgcn_perm(v1[w], v0[w], 0x07060302u);
        }
    }
    __syncthreads();
    for (int half = 0; half < 2; ++half) {
        unsigned zh[4][4], gh4[4][4], za[4][4], ga4[4][4];
#pragma unroll
        for (int q = 0; q < 4; ++q) {
            const int tt = wave + 8 * (4 * half + q); const size_t token = (size_t)(tok0 + tt);
            const LAS unsigned* rw = (const LAS unsigned*)(lds + tt * TROWB);
            const unsigned* gh = (const unsigned*)(proj + token * NPROJ + PJ_GH); const unsigned* ga = (const unsigned*)(proj + token * NPROJ + PJ_GA);
            const unsigned* ya = (const unsigned*)(YA + token * DH);
#pragma unroll
            for (int k = 0; k < 4; ++k) { zh[q][k] = rw[lane + 64 * k]; gh4[q][k] = gh[lane + 64 * k]; za[q][k] = ya[lane + 64 * k]; ga4[q][k] = ga[lane + 64 * k]; }
        }
#pragma unroll
        for (int q = 0; q < 4; ++q) {
            const int tt = wave + 8 * (4 * half + q); const size_t token = (size_t)(tok0 + tt);
            float ssh = 0.f, ssa = 0.f;
#pragma unroll
            for (int k = 0; k < 4; ++k) { const float a = bf_lo(zh[q][k]), bq = bf_hi(zh[q][k]), c2 = bf_lo(za[q][k]), d2 = bf_hi(za[q][k]); ssh += a * a + bq * bq; ssa += c2 * c2 + d2 * d2; }
            const float rh = 1.0f / sqrtf(wave_sum(ssh) * (1.0f / 512.0f) + EPS), ra = 1.0f / sqrtf(wave_sum(ssa) * (1.0f / 512.0f) + EPS);
            unsigned* yo = (unsigned*)(Y + token * DM);
#pragma unroll
            for (int k = 0; k < 4; ++k) {
                yo[lane + 64 * k] = pk2(bf_lo(zh[q][k]) * rh * silu_f(bf_lo(gh4[q][k])), bf_hi(zh[q][k]) * rh * silu_f(bf_hi(gh4[q][k])));
                yo[256 + lane + 64 * k] = pk2(bf_lo(za[q][k]) * ra * silu_f(bf_lo(ga4[q][k])), bf_hi(za[q][k]) * ra * silu_f(bf_hi(ga4[q][k])));
            }
        }
    }
    __syncthreads();
}

__device__ __forceinline__ void grid_bar(unsigned* ctr, unsigned target) {
    asm volatile("s_waitcnt vmcnt(0) lgkmcnt(0)" ::: "memory");
    __syncthreads();
    if (threadIdx.x == 0) {
        __builtin_amdgcn_fence(__ATOMIC_RELEASE, "agent");
        asm volatile("s_waitcnt vmcnt(0)" ::: "memory");
        __hip_atomic_fetch_add(ctr, 1u, __ATOMIC_RELAXED, __HIP_MEMORY_SCOPE_AGENT);
        while (__hip_atomic_load(ctr, __ATOMIC_RELAXED, __HIP_MEMORY_SCOPE_AGENT) < target) __builtin_amdgcn_s_sleep(1);
        __builtin_amdgcn_fence(__ATOMIC_ACQUIRE, "agent");
        asm volatile("s_waitcnt vmcnt(0)" ::: "memory");
    }
    __syncthreads();
}

__global__ void __launch_bounds__(NTHREADS, 2) hymba_fwd(Params p) {
    extern __shared__ __attribute__((aligned(16))) unsigned char lds_raw[];
    LAS unsigned char* lds = (LAS unsigned char*)lds_raw;
    cg::grid_group grid = cg::this_grid();
    unsigned* ctl = (unsigned*)(p.ws + WS_CTL);
    int tid = threadIdx.x, lane = tid & 63, wave = __builtin_amdgcn_readfirstlane(tid >> 6);
#define FRESH_IDS() do { tid = threadIdx.x; asm volatile("" : "+v"(tid)); lane = tid & 63; wave = __builtin_amdgcn_readfirstlane(tid >> 6); } while (0)

    if (blockIdx.x == 0 && tid < 3) __hip_atomic_store(ctl + 64 * tid, 0u, __ATOMIC_RELAXED, __HIP_MEMORY_SCOPE_AGENT);
    p0_prologue(p, lds, tid, wave, lane);
    grid.sync();
    FRESH_IDS();
    {
        pg8::Gemm g{(const bf16_t*)(p.ws + WS_XB), (const bf16_t*)(p.ws + WS_WIN), NTOK, NIN, DM};
        pg8::StaticOrder S; S.init(NTOK, NIN, (int)gridDim.x, (int)blockIdx.x);
        EpiIn E{(bf16_t*)(p.ws + WS_HYT), (bf16_t*)(p.ws + WS_PROJ)};
        pg8::gemm_phase2<EpiIn, pg8::StaticOrder, GEMM_ALIGN, GEMM_SP2>(lds, g, S, E);
    }
    grid_bar(ctl + 0, gridDim.x);
    FRESH_IDS();
    {
        const int vcu = ((gridDim.x & 7) == 0) ? (int)((blockIdx.x & 7) * (gridDim.x >> 3) + (blockIdx.x >> 3)) : (int)blockIdx.x;
        for (int u = vcu; u < NB * 16; u += gridDim.x) attn_unit(p, lds, u, tid, wave, lane);
    }
    FRESH_IDS();
    {
        const int vcu = ((gridDim.x & 7) == 0) ? (int)((blockIdx.x & 7) * (gridDim.x >> 3) + (blockIdx.x >> 3)) : (int)blockIdx.x;
        for (int u = vcu; u < DH; u += gridDim.x) hyena_unit(p, lds, u, tid, wave, lane);
    }
    grid_bar(ctl + 64, gridDim.x);
    FRESH_IDS();
    {
        LAS float* scr = (LAS float*)(lds + wave * 16384);
        bf16_t* WoutT = (bf16_t*)(p.ws + WS_WOUT);
#pragma unroll 1
        for (int it = blockIdx.x * 8 + wave; it < (DM / 64) * (DM / 32); it += gridDim.x * 8) {
            const int kb = it / (DM / 32);
            p0_transpose_item(p.in[19], (kb < 8) ? p.in[17] : (p.in[18] - 512), DM, DM, WoutT, scr, it, lane);
        }
        __syncthreads();
    }
    for (int u = blockIdx.x; u < NTOK / 64; u += gridDim.x) p3_unit(p, lds, u, tid, wave, lane);
    grid_bar(ctl + 128, gridDim.x);
    FRESH_IDS();
    {
        pg8::Gemm g{(const bf16_t*)(p.ws + WS_Y), (const bf16_t*)(p.ws + WS_WOUT), NTOK, DM, DM};
        pg8::StaticOrder S; S.init(NTOK, DM, (int)gridDim.x, (int)blockIdx.x);
        EpiOut E{p.in[0], p.out};
        pg8::gemm_phase2<EpiOut, pg8::StaticOrder, GEMM_ALIGN, GEMM_SP2>(lds, g, S, E);
    }
}

extern "C" void kernel_launch(void* const* d_in, const int* in_sizes, int n_in, void* d_out, int out_size, void* d_ws, size_t ws_size, hipStream_t stream) {
    static int grid = 0;
    if (grid == 0) {
        if (n_in != 20 || ws_size < WS_END) { fprintf(stderr, "kernel_launch: unexpected inputs (n_in %d, ws %zu < %zu)\n", n_in, ws_size, (size_t)WS_END); grid = -1; return; }
        int dev = 0, cus = 0, per_cu = 0;
        hipGetDevice(&dev);
        hipDeviceGetAttribute(&cus, hipDeviceAttributeMultiprocessorCount, dev);
        if (hipFuncSetAttribute((const void*)hymba_fwd, hipFuncAttributeMaxDynamicSharedMemorySize, LDS_BYTES) != hipSuccess) fprintf(stderr, "kernel_launch: hipFuncSetAttribute failed\n");
        if (hipOccupancyMaxActiveBlocksPerMultiprocessor(&per_cu, (const void*)hymba_fwd, NTHREADS, LDS_BYTES) != hipSuccess || per_cu < 1) { fprintf(stderr, "kernel_launch: occupancy query gave %d\n", per_cu); per_cu = 1; }
        (void)hipGetLastError();
        grid = cus * (per_cu > 1 ? 1 : per_cu);
        if (grid > 256) grid = 256;
    }
    if (grid < 0) return;
    Params p{};
    for (int i = 0; i < 20; ++i) p.in[i] = (const float*)d_in[i];
    p.out = (float*)d_out; p.ws = (unsigned char*)d_ws;
    void* args[] = {&p};
    hipError_t e = hipLaunchCooperativeKernel((const void*)hymba_fwd, dim3(grid), dim3(NTHREADS), args, LDS_BYTES, stream);
    if (e != hipSuccess) fprintf(stderr, "cooperative launch failed: %s (grid %d)\n", hipGetErrorString(e), grid);
}
```
